# Optimizing an MI355X kernel written in HIP

```python
import math
import jax, jax.numpy as jnp
from jax import lax
import numpy as np

D_MODEL = 1024
BATCH = 2
SEQ = 16384
DEPTH = 2
DEC_BATCH = 4
DEC_SEQ = 8192
PAST_LEN = 128

N_MEM = 256
EPS = 1e-6
HA = 4
DK_A = 128
DV_A = 256
CHUNK = 128
HB = 8
DH_B = 64
QBLOCK = 128
N_BUCKETS = 32
MAX_DIST = 128
HC = 4
DC = D_MODEL // HC
D_FF = 4 * D_MODEL
N_A = (DEPTH + 1) // 2
N_B = DEPTH // 2

kernel_name = 'hybrid_mlstm_diffattn_encoder'


def lambda_init_fn(layer):
    return 0.8 - 0.6 * math.exp(-0.3 * layer)


def rmsnorm(x, g):
    xf = x.astype(jnp.float32)
    y = xf * lax.rsqrt(jnp.mean(xf * xf, axis=-1, keepdims=True) + EPS)
    return (y * g.astype(jnp.float32)).astype(x.dtype)


def mlstm_scan(q, k, v, ig, lf):
    B, H, S, dk = q.shape
    dv = v.shape[-1]
    nc = S // CHUNK
    def chunks(a):
        return jnp.moveaxis(a.reshape(a.shape[:2] + (nc, CHUNK) + a.shape[3:]), 2, 0)
    tril = jnp.tril(jnp.ones((CHUNK, CHUNK), dtype=bool))

    def step(carry, inp):
        C, n, m = carry
        qc, kc, vc, igc, lfc = inp
        b = jnp.cumsum(lfc, axis=-1)
        dlog = jnp.where(tril, b[..., :, None] - b[..., None, :] + igc[..., None, :], -jnp.inf)
        inter = b + m[..., None]
        m_t = jnp.maximum(inter, jnp.max(dlog, axis=-1))
        s = jnp.einsum('bhtd,bhsd->bhts', qc, kc) * jnp.exp(dlog - m_t[..., None])
        iw = jnp.exp(inter - m_t)
        num = iw[..., None] * jnp.einsum('bhtd,bhde->bhte', qc, C) + jnp.einsum('bhts,bhse->bhte', s, vc)
        den = iw * jnp.einsum('bhtd,bhd->bht', qc, n) + jnp.sum(s, axis=-1)
        h = num / jnp.maximum(jnp.abs(den), jnp.exp(-m_t))[..., None]
        bl = b[..., -1]
        wlog = bl[..., None] - b + igc
        m_new = jnp.maximum(bl + m, jnp.max(wlog, axis=-1))
        w = jnp.exp(wlog - m_new[..., None])
        decay = jnp.exp(bl + m - m_new)
        C_new = decay[..., None, None] * C + jnp.einsum('bhs,bhsd,bhse->bhde', w, kc, vc)
        n_new = decay[..., None] * n + jnp.einsum('bhs,bhsd->bhd', w, kc)
        return (C_new, n_new, m_new), h

    init = (jnp.zeros((B, H, dk, dv), jnp.float32), jnp.zeros((B, H, dk), jnp.float32), jnp.zeros((B, H), jnp.float32))
    _, hs = lax.scan(step, init, (chunks(q), chunks(k), chunks(v), chunks(ig), chunks(lf)))
    return jnp.moveaxis(hs, 0, 2).reshape(B, H, S, dv)


def mlstm_mixer(xn, w_in, w_gate, b_gate, norm_g, w_out):
    B, S, _ = xn.shape
    q, k, v, o = jnp.split(xn @ w_in, [HA * DK_A, 2 * HA * DK_A, 2 * HA * DK_A + HA * DV_A], axis=-1)
    def heads(a, d):
        return a.reshape(B, S, HA, d).transpose(0, 2, 1, 3).astype(jnp.float32)
    q = heads(q, DK_A)
    k = heads(k, DK_A) * (DK_A ** -0.5)
    v = heads(v, DV_A)
    gates = (xn @ w_gate + b_gate).astype(jnp.float32).reshape(B, S, 4, HA).transpose(2, 0, 3, 1)
    ig_f, fg_f, ig_b, fg_b = gates[0], gates[1], gates[2], gates[3]
    h_f = mlstm_scan(q, k, v, ig_f, jax.nn.log_sigmoid(fg_f))
    fl = lambda a: jnp.flip(a, axis=2)
    h_b = fl(mlstm_scan(fl(q), fl(k), fl(v), fl(ig_b), fl(jax.nn.log_sigmoid(fg_b))))
    h = h_f + h_b
    hf = h * lax.rsqrt(jnp.mean(h * h, axis=-1, keepdims=True) + EPS)
    hf = hf.transpose(0, 2, 1, 3).reshape(B, S, HA * DV_A) * norm_g.astype(jnp.float32)
    out = hf * jax.nn.sigmoid(o.astype(jnp.float32))
    return out.astype(xn.dtype) @ w_out


def rel_bucket(rp):
    half = N_BUCKETS // 2
    max_exact = half // 2
    ret = (rp > 0).astype(jnp.int32) * half
    n = jnp.abs(rp)
    nf = jnp.maximum(n, 1).astype(jnp.float32)
    large = max_exact + (jnp.log(nf / max_exact) / math.log(MAX_DIST / max_exact) * (half - max_exact)).astype(jnp.int32)
    large = jnp.minimum(large, half - 1)
    return ret + jnp.where(n < max_exact, n, large)


def diff_attention(xn, w_qkv, lam_vecs, subln_g, w_out, rel_table, lambda_init):
    B, S, _ = xn.shape
    nblk = S // QBLOCK
    q, k, v = jnp.split(xn @ w_qkv, [2 * HB * DH_B, 4 * HB * DH_B], axis=-1)
    q = q.reshape(B, S, HB, 2, DH_B)
    k = k.reshape(B, S, HB, 2, DH_B)
    k1 = k[..., 0, :].transpose(0, 2, 1, 3)
    k2 = k[..., 1, :].transpose(0, 2, 1, 3)
    v = v.reshape(B, S, HB, 2 * DH_B).transpose(0, 2, 1, 3)
    def to_blocks(a):
        return a.reshape(B, nblk, QBLOCK, HB, DH_B).transpose(1, 0, 3, 2, 4)
    q1b = to_blocks(q[..., 0, :])
    q2b = to_blocks(q[..., 1, :])
    lv = lam_vecs.astype(jnp.float32)
    lam = jnp.exp(jnp.sum(lv[0] * lv[1])) - jnp.exp(jnp.sum(lv[2] * lv[3])) + lambda_init
    kpos = jnp.arange(S, dtype=jnp.int32)
    scale = DH_B ** -0.5
    table = rel_table.astype(jnp.float32)

    def block(args):
        q1, q2, q0 = args
        qpos = q0 + jnp.arange(QBLOCK, dtype=jnp.int32)
        bias = jnp.transpose(table[rel_bucket(kpos[None, :] - qpos[:, None])], (2, 0, 1))[None]
        p1 = jax.nn.softmax(jnp.einsum('bhqd,bhkd->bhqk', q1, k1).astype(jnp.float32) * scale + bias, axis=-1)
        p2 = jax.nn.softmax(jnp.einsum('bhqd,bhkd->bhqk', q2, k2).astype(jnp.float32) * scale + bias, axis=-1)
        a = (p1 - lam * p2).astype(v.dtype)
        return jnp.einsum('bhqk,bhke->bhqe', a, v)

    o = lax.map(block, (q1b, q2b, jnp.arange(nblk, dtype=jnp.int32) * QBLOCK))
    o = rmsnorm(o, subln_g) * (1.0 - lambda_init)
    o = o.transpose(1, 0, 3, 2, 4).reshape(B, S, HB * 2 * DH_B)
    return o @ w_out


def cross_attention(xn, memn, w_q, w_kv, w_out):
    B, S, _ = xn.shape
    M = memn.shape[1]
    q = (xn @ w_q).reshape(B, S, HC, DC)
    k, v = jnp.split(memn @ w_kv, 2, axis=-1)
    k = k.reshape(B, M, HC, DC)
    v = v.reshape(B, M, HC, DC)
    p = jax.nn.softmax(jnp.einsum('bshd,bmhd->bhsm', q, k).astype(jnp.float32) * (DC ** -0.5), axis=-1).astype(v.dtype)
    o = jnp.einsum('bhsm,bmhd->bshd', p, v).reshape(B, S, HC * DC)
    return o @ w_out


def squared_relu_mlp(xn, w1, w2):
    return jnp.square(jax.nn.relu(xn @ w1)) @ w2


def encoder(x, mem, g_mix, g_cross, g_mem, g_mlp, g_final, a_w_in, a_w_gate, a_b_gate, a_norm_g, a_w_out,
            b_w_qkv, b_lambda, b_subln_g, b_w_out, rel_bias, c_w_q, c_w_kv, c_w_out, f_w1, f_w2):
    for i in range(DEPTH):
        xn = rmsnorm(x, g_mix[i])
        j = i // 2
        if i % 2 == 0:
            x = x + mlstm_mixer(xn, a_w_in[j], a_w_gate[j], a_b_gate[j], a_norm_g[j], a_w_out[j])
        else:
            x = x + diff_attention(xn, b_w_qkv[j], b_lambda[j], b_subln_g[j], b_w_out[j], rel_bias, lambda_init_fn(i))
        x = x + cross_attention(rmsnorm(x, g_cross[i]), rmsnorm(mem, g_mem[i]), c_w_q[i], c_w_kv[i], c_w_out[i])
        x = x + squared_relu_mlp(rmsnorm(x, g_mlp[i]), f_w1[i], f_w2[i])
    return rmsnorm(x, g_final)


def setup_inputs(seed: int = 0) -> dict:
    key = jax.random.key(seed)
    ks = jax.random.split(key, 32)
    nrm = lambda k, shape, s: jax.random.normal(k, shape, jnp.float32) * s
    gain = lambda k, shape: 1.0 + nrm(k, shape, 0.02)
    gate_off = jnp.array([0.0, 3.0, 0.0, 3.0], jnp.float32)[None, :, None]
    gate_scale = jnp.array([0.1, 0.5, 0.1, 0.5], jnp.float32)[None, :, None]
    a_b_gate = (gate_off + gate_scale * jax.random.normal(ks[9], (N_A, 4, HA), jnp.float32)).reshape(N_A, 4 * HA)
    return {
        'x_prompt': nrm(ks[0], (BATCH, SEQ, D_MODEL), 1.0),
        'x_sample': nrm(ks[1], (DEC_BATCH, DEC_SEQ, D_MODEL), 1.0),
        'mem_prompt': nrm(ks[2], (BATCH, N_MEM, D_MODEL), 1.0),
        'mem_sample': nrm(ks[3], (DEC_BATCH, N_MEM, D_MODEL), 1.0),
        'g_mix': gain(ks[4], (DEPTH, D_MODEL)),
        'g_cross': gain(ks[5], (DEPTH, D_MODEL)),
        'g_mem': gain(ks[6], (DEPTH, D_MODEL)),
        'g_mlp': gain(ks[7], (DEPTH, D_MODEL)),
        'g_final': gain(ks[8], (D_MODEL,)),
        'a_w_in': nrm(ks[10], (N_A, D_MODEL, 2 * HA * DK_A + 2 * HA * DV_A), D_MODEL ** -0.5),
        'a_w_gate': nrm(ks[11], (N_A, D_MODEL, 4 * HA), D_MODEL ** -0.5),
        'a_b_gate': a_b_gate,
        'a_norm_g': gain(ks[12], (N_A, HA * DV_A)),
        'a_w_out': nrm(ks[13], (N_A, HA * DV_A, D_MODEL), (HA * DV_A) ** -0.5),
        'b_w_qkv': nrm(ks[14], (N_B, D_MODEL, 6 * HB * DH_B), D_MODEL ** -0.5),
        'b_lambda': nrm(ks[15], (N_B, 4, DH_B), 0.1),
        'b_subln_g': gain(ks[16], (N_B, 2 * DH_B)),
        'b_w_out': nrm(ks[17], (N_B, 2 * HB * DH_B, D_MODEL), (2 * HB * DH_B) ** -0.5),
        'rel_bias': nrm(ks[18], (N_BUCKETS, HB), 0.1),
        'c_w_q': nrm(ks[19], (DEPTH, D_MODEL, HC * DC), D_MODEL ** -0.5),
        'c_w_kv': nrm(ks[20], (DEPTH, D_MODEL, 2 * HC * DC), D_MODEL ** -0.5),
        'c_w_out': nrm(ks[21], (DEPTH, HC * DC, D_MODEL), (HC * DC) ** -0.5),
        'f_w1': nrm(ks[22], (DEPTH, D_MODEL, D_FF), D_MODEL ** -0.5),
        'f_w2': nrm(ks[23], (DEPTH, D_FF, D_MODEL), D_FF ** -0.5),
    }


def reference(x_prompt, x_sample, mem_prompt, mem_sample, g_mix, g_cross, g_mem, g_mlp, g_final,
              a_w_in, a_w_gate, a_b_gate, a_norm_g, a_w_out, b_w_qkv, b_lambda, b_subln_g, b_w_out,
              rel_bias, c_w_q, c_w_kv, c_w_out, f_w1, f_w2):
    y_prompt = encoder(x_prompt, mem_prompt, g_mix, g_cross, g_mem, g_mlp, g_final, a_w_in, a_w_gate, a_b_gate,
                       a_norm_g, a_w_out, b_w_qkv, b_lambda, b_subln_g, b_w_out, rel_bias, c_w_q, c_w_kv, c_w_out,
                       f_w1, f_w2)
    y_sample = encoder(x_sample, mem_sample, g_mix, g_cross, g_mem, g_mlp, g_final, a_w_in, a_w_gate, a_b_gate,
                       a_norm_g, a_w_out, b_w_qkv, b_lambda, b_subln_g, b_w_out, rel_bias, c_w_q, c_w_kv, c_w_out,
                       f_w1, f_w2)
    return (y_prompt, y_sample)
```

```cpp
#include <hip/hip_runtime.h>
#include <hip/hip_cooperative_groups.h>
#include <cstdio>
#include <cstdint>
namespace cg = cooperative_groups;

typedef unsigned short bf16_t;
typedef short bf16x8 __attribute__((ext_vector_type(8)));
typedef short s16x4 __attribute__((ext_vector_type(4)));
typedef float f32x4 __attribute__((ext_vector_type(4)));
typedef float f32x8 __attribute__((ext_vector_type(8)));
typedef float f32x16 __attribute__((ext_vector_type(16)));
typedef unsigned u32x4 __attribute__((ext_vector_type(4)));
typedef unsigned u32x2 __attribute__((ext_vector_type(2)));
#define LAS __attribute__((address_space(3)))
#define DI __device__ __forceinline__

constexpr int T = 65536, DM = 1024, TP = 32768;
constexpr float EPS = 1e-6f;
constexpr int NTHREADS = 512;
constexpr int LDS_BYTES = 147456;
constexpr float LAMBDA_INIT1 = 0.35550906759f;
#define REP_ATTN 1
#define REP_SCAN 1
#define REP_GEMM 1

constexpr size_t MiB = 1ull << 20;
constexpr size_t O_WA = 0;
constexpr size_t O_WB = O_WA + 1280ull * 1024 * 2;
constexpr size_t O_WO = O_WB + 3 * MiB;
constexpr size_t O_WAOUT = O_WO + 2 * MiB;
constexpr size_t O_WQKV = O_WAOUT + 2 * MiB;
constexpr size_t O_WBOUT = O_WQKV + 6 * MiB;
constexpr size_t O_LAYER = O_WBOUT + 2 * MiB;
constexpr size_t L_WQG = 0, L_WKV = 2 * MiB, L_WCOUT = 6 * MiB, L_W1 = 8 * MiB, L_W2 = 16 * MiB, L_SIZE = 24 * MiB;
constexpr size_t O_MEMB = O_LAYER + 2 * L_SIZE;
constexpr size_t O_KVM = O_MEMB + 3 * MiB;
constexpr size_t O_MB = O_KVM + 6 * MiB;
constexpr size_t O_NB = O_MB + 12 * MiB;
constexpr size_t O_GATES = O_NB + 12 * MiB;
constexpr size_t O_ROWSS = O_GATES + 4 * MiB;
constexpr size_t O_MISC = O_ROWSS + 8 * MiB;
constexpr size_t O_R1 = O_MISC + 1 * MiB;
constexpr size_t O_R2 = O_R1 + 128 * MiB;
constexpr size_t O_R0 = O_R2 + 128 * MiB;
constexpr size_t WS_END = O_R0 + 128 * MiB;

struct Params { const float* in[24]; float* out; unsigned char* ws; int ph_lo, ph_hi; };

DI unsigned cvt_pk_bf16(float lo, float hi) { unsigned r; asm("v_cvt_pk_bf16_f32 %0, %1, %2" : "=v"(r) : "v"(lo), "v"(hi)); return r; }
DI float bflo(unsigned u) { return __uint_as_float(u << 16); }
DI float bfhi(unsigned u) { return __uint_as_float(u & 0xffff0000u); }
DI float rstd_of(float ss) { return rsqrtf(ss * (1.0f / 1024.0f) + EPS); }
DI float rstd4(const float* ss, int row) { return rstd_of((ss[row] + ss[T + row]) + (ss[2 * T + row] + ss[3 * T + row])); }
DI int lane_id() { return (int)__builtin_amdgcn_mbcnt_hi(~0u, __builtin_amdgcn_mbcnt_lo(~0u, 0u)); }
DI int tid_of(int wv) { return wv * 64 + lane_id(); }
DI int batch_of_row(int row) { return row < TP ? (row >> 14) : 2 + ((row - TP) >> 13); }

namespace pg8 {
constexpr int BM = 256, BK = 64, HALF = 128, HTB = HALF * BK * 2, STAGE_BYTES = 8 * HTB, NXCD = 8, WGM = 8;
DI int lds_byte(int r, int c) { const int st = (r >> 4) * 2 + (c >> 5), rr = r & 15, cc = c & 31, ob = rr * 64 + cc * 2; return st * 1024 + (ob ^ (((ob >> 9) & 1) << 5)); }
DI void stage_rc(int b, int& R, int& C) { const int st = b / 1024, sb = b % 1024, swz = sb ^ (((sb >> 9) & 1) << 5); R = (st >> 1) * 16 + swz / 64; C = (st & 1) * 32 + (swz % 64) / 2; }
DI int perm32(int rho) { const int n = rho >> 4, i = rho & 15; return 8 * (i >> 2) + 4 * n + (i & 3); }

struct Unit { const char* A; const char* B; int row0, col0; size_t coff; };

DI bool static_tile(int i, int G, int c, int nM, int nN, int& pm, int& pn) {
    const int nwg = nM * nN; const long L = (long)i * G + c; if (L >= nwg) return false;
    int wgid = (int)L; { const int q = nwg / NXCD, r = nwg % NXCD, xcd = wgid % NXCD, off = wgid / NXCD; wgid = (xcd < r ? xcd * (q + 1) : r * (q + 1) + (xcd - r) * q) + off; }
    const int nig = WGM * nN, gid = wgid / nig, fm = gid * WGM, gsz = (nM - fm) < WGM ? (nM - fm) : WGM;
    pm = fm + ((wgid % nig) % gsz); pn = (wgid % nig) / gsz; return true;
}
struct Sched {
    int nM, nN, G, c, pm0; const char* A; const char* B; size_t a_tile, b_tile, b_batch;
    DI bool next(int i, Unit& u) const {
        int pm, pn; if (!static_tile(i, G, c, nM, nN, pm, pn)) return false;
        pm += pm0; u.row0 = pm * 256; u.col0 = pn * 256; u.coff = 0;
        u.A = A + (size_t)pm * a_tile; u.B = B + (size_t)pn * b_tile + (b_batch ? (size_t)batch_of_row(u.row0) * b_batch : 0);
        return true;
    }
};
struct SchedM {
    int G, c; const char* kvm; const char* wqg;
    DI bool next(int i, Unit& u) const { const int L = i * G + c; if (L >= 96) return false; const int b = L / 16, h = (L >> 2) & 3, t = L & 3;
        u.A = kvm + ((size_t)b * 256 * 2048 + h * 256) * 2; u.B = wqg + ((size_t)t * 256 * 1024 + h * 256) * 2; u.row0 = h * 256; u.col0 = t * 256; u.coff = (size_t)b * 1024 * 1024; return true; }
};
struct SchedN {
    int G, c; const char* kvm; const char* wc;
    DI bool next(int i, Unit& u) const { const int L = i * G + c; if (L >= 96) return false; const int b = L / 16, h = (L >> 2) & 3, t = L & 3;
        u.A = wc + ((size_t)t * 256 * 1024 + h * 256) * 2; u.B = kvm + ((size_t)b * 256 * 2048 + 1024 + h * 256) * 2; u.row0 = t * 256; u.col0 = h * 256; u.coff = (size_t)b * 1024 * 1024; return true; }
};

typedef f32x4 Acc[2][2][4][2];

template <bool MAX> DI void row_allreduce(float (&v)[8], LAS float* st, int wr, int wc, int fr, int fq) {
#pragma unroll
    for (int i = 0; i < 8; ++i) {
        float a = __shfl_xor(v[i], 16), b;
        v[i] = MAX ? fmaxf(v[i], a) : v[i] + a;
        b = __shfl_xor(v[i], 32);
        v[i] = MAX ? fmaxf(v[i], b) : v[i] + b;
    }
    if (fq == 0) {
#pragma unroll
        for (int i = 0; i < 8; ++i) st[((i >> 2) * 128 + wr * 64 + (i & 3) * 16 + fr) * 4 + wc] = v[i];
    }
    __syncthreads();
#pragma unroll
    for (int i = 0; i < 8; ++i) { const f32x4 x = *(const LAS f32x4*)&st[((i >> 2) * 128 + wr * 64 + (i & 3) * 16 + fr) * 4];
        v[i] = MAX ? fmaxf(fmaxf(x[0], x[1]), fmaxf(x[2], x[3])) : (x[0] + x[1]) + (x[2] + x[3]); }
}
DI void st_bf16x8(bf16_t* p, f32x4 v0, f32x4 v1) { u32x4 w; w.x = cvt_pk_bf16(v0[0], v0[1]); w.y = cvt_pk_bf16(v0[2], v0[3]); w.z = cvt_pk_bf16(v1[0], v1[1]); w.w = cvt_pk_bf16(v1[2], v1[3]); *(u32x4*)p = w; }

struct EpiPlain { bf16_t* O; int ldc; const float* ss;
    DI void operator()(const Acc& acc, const Unit& u, int wr, int wc, int fr, int fq, LAS float*) const {
        const int r0 = u.row0 + wr * 64 + fr, c0 = u.col0 + wc * 32 + 8 * fq;
#pragma unroll
        for (int ai = 0; ai < 2; ++ai)
#pragma unroll
            for (int m = 0; m < 4; ++m) { const int row = r0 + ai * 128 + m * 16; const float sc = ss ? rstd_of(ss[row]) : 1.0f;
                bf16_t* rp = O + u.coff + (size_t)row * ldc + c0;
#pragma unroll
                for (int bj = 0; bj < 2; ++bj) st_bf16x8(rp + bj * 128, acc[ai][bj][m][0] * sc, acc[ai][bj][m][1] * sc); }
    } };
struct EpiQKVh { bf16_t* O; const float* ss; int rowbase;
    DI void operator()(const Acc& acc, const Unit& u, int wr, int wc, int fr, int fq, LAS float*) const {
        const int r0 = u.row0 + wr * 64 + fr, ph0 = u.col0 >> 7;
#pragma unroll
        for (int ai = 0; ai < 2; ++ai)
#pragma unroll
            for (int m = 0; m < 4; ++m) { const int row = r0 + ai * 128 + m * 16; const float sc = rstd4(ss, row);
#pragma unroll
                for (int bj = 0; bj < 2; ++bj) st_bf16x8(O + ((size_t)(ph0 + bj) * TP + (row - rowbase)) * 128 + wc * 32 + 8 * fq, acc[ai][bj][m][0] * sc, acc[ai][bj][m][1] * sc); }
    } };
struct EpiColScale { bf16_t* O; int ldc; const float* ss;
    DI void operator()(const Acc& acc, const Unit& u, int wr, int wc, int fr, int fq, LAS float*) const {
        const int r0 = u.row0 + wr * 64 + fr, c0 = u.col0 + wc * 32 + 8 * fq;
        f32x4 s[2][2];
#pragma unroll
        for (int bj = 0; bj < 2; ++bj)
#pragma unroll
            for (int n = 0; n < 2; ++n) { const float* sp = ss + c0 + bj * 128 + n * 4; const f32x4 x = (*(const f32x4*)sp + *(const f32x4*)(sp + T)) + (*(const f32x4*)(sp + 2 * T) + *(const f32x4*)(sp + 3 * T)); s[bj][n] = (f32x4){rstd_of(x[0]), rstd_of(x[1]), rstd_of(x[2]), rstd_of(x[3])}; }
#pragma unroll
        for (int ai = 0; ai < 2; ++ai)
#pragma unroll
            for (int m = 0; m < 4; ++m) { const int row = r0 + ai * 128 + m * 16;
#pragma unroll
                for (int bj = 0; bj < 2; ++bj) st_bf16x8(O + ((size_t)((u.col0 >> 7) + bj) * 1536 + row) * 128 + wc * 32 + 8 * fq, acc[ai][bj][m][0] * s[bj][0], acc[ai][bj][m][1] * s[bj][1]); }
    } };
DI float logsigmoid(float x) { return fminf(x, 0.f) - log1pf(__expf(-fabsf(x))); }
struct EpiQKG { bf16_t* Q; bf16_t* K; float* gates; const float* bg; const float* ss;
    DI void operator()(const Acc& acc, const Unit& u, int wr, int wc, int fr, int fq, LAS float*) const {
        const int r0 = u.row0 + wr * 64 + fr, c0 = u.col0 + wc * 32 + 8 * fq;
        if (u.col0 < 1024) {
            bf16_t* base = ((u.col0 < 512) ? Q : K) + wc * 32 + 8 * fq; const int h0 = (u.col0 & 511) >> 7;
#pragma unroll
            for (int ai = 0; ai < 2; ++ai)
#pragma unroll
                for (int m = 0; m < 4; ++m) { const int row = r0 + ai * 128 + m * 16; const float sc = rstd4(ss, row);
#pragma unroll
                    for (int bj = 0; bj < 2; ++bj) st_bf16x8(base + ((size_t)(h0 + bj) * T + row) * 128, acc[ai][bj][m][0] * sc, acc[ai][bj][m][1] * sc); }
        } else if (wc == 0 && fq < 2) {
            const int j0 = 8 * fq;
            float b[8];
#pragma unroll
            for (int j = 0; j < 8; ++j) b[j] = bg[j0 + j];
#pragma unroll
            for (int ai = 0; ai < 2; ++ai)
#pragma unroll
                for (int m = 0; m < 4; ++m) { const int row = r0 + ai * 128 + m * 16; const float sc = rstd4(ss, row);
                    float v[8];
#pragma unroll
                    for (int j = 0; j < 8; ++j) { v[j] = acc[ai][0][m][j >> 2][j & 3] * sc + b[j]; }
#pragma unroll
                    for (int j = 4; j < 8; ++j) v[j] = logsigmoid(v[j]);
                    float* gp = gates + (size_t)row * 16 + j0;
                    *(f32x4*)gp = (f32x4){v[0], v[1], v[2], v[3]}; *(f32x4*)(gp + 4) = (f32x4){v[4], v[5], v[6], v[7]}; }
        }
    } };
struct EpiOGate { bf16_t* HF; const bf16_t* HB; const float* ng; const float* ss;
    DI void operator()(const Acc& acc, const Unit& u, int wr, int wc, int fr, int fq, LAS float* st) const {
        const int r0 = u.row0 + wr * 64 + fr, c0 = u.col0 + wc * 32 + 8 * fq;
        float hs[8];
#pragma unroll
        for (int i = 0; i < 8; ++i) { const int row = r0 + (i >> 2) * 128 + (i & 3) * 16; float s = 0.f;
#pragma unroll
            for (int bj = 0; bj < 2; ++bj) { const u32x4 a = *(const u32x4*)(HF + (size_t)row * 1024 + c0 + bj * 128), b = *(const u32x4*)(HB + (size_t)row * 1024 + c0 + bj * 128);
#pragma unroll
                for (int k = 0; k < 4; ++k) { const float x = bflo(a[k]) + bflo(b[k]), y = bfhi(a[k]) + bfhi(b[k]); s += x * x + y * y; } }
            hs[i] = s; }
        row_allreduce<false>(hs, st, wr, wc, fr, fq);
        float g[2][8];
#pragma unroll
        for (int bj = 0; bj < 2; ++bj) { const f32x4 x = *(const f32x4*)(ng + c0 + bj * 128), y = *(const f32x4*)(ng + c0 + bj * 128 + 4);
            g[bj][0] = x[0]; g[bj][1] = x[1]; g[bj][2] = x[2]; g[bj][3] = x[3]; g[bj][4] = y[0]; g[bj][5] = y[1]; g[bj][6] = y[2]; g[bj][7] = y[3]; }
#pragma unroll
        for (int i = 0; i < 8; ++i) { const int ai = i >> 2, m = i & 3, row = r0 + ai * 128 + m * 16; const float sc = rstd4(ss, row), hn = rsqrtf(hs[i] * (1.0f / 256.0f) + EPS);
#pragma unroll
            for (int bj = 0; bj < 2; ++bj) { bf16_t* hp = HF + (size_t)row * 1024 + c0 + bj * 128; const u32x4 a = *(const u32x4*)hp, b = *(const u32x4*)(HB + (size_t)row * 1024 + c0 + bj * 128);
                float o[8];
#pragma unroll
                for (int k = 0; k < 4; ++k) { o[2 * k] = bflo(a[k]) + bflo(b[k]); o[2 * k + 1] = bfhi(a[k]) + bfhi(b[k]); }
#pragma unroll
                for (int k = 0; k < 8; ++k) { const float z = acc[ai][bj][m][k >> 2][k & 3] * sc; o[k] = o[k] * hn * g[bj][k] * (1.0f / (1.0f + __expf(-z))); }
                st_bf16x8(hp, (f32x4){o[0], o[1], o[2], o[3]}, (f32x4){o[4], o[5], o[6], o[7]}); } }
    } };
template <int MODE> struct EpiRes { const float* xlo; const float* xhi; float* out; bf16_t* xb; float* ssout;
    DI void operator()(const Acc& acc, const Unit& u, int wr, int wc, int fr, int fq, LAS float* st) const {
        const int r0 = u.row0 + wr * 64 + fr, c0 = u.col0 + wc * 32 + 8 * fq;
        const float* xo = (u.row0 < TP) ? xlo : xhi - (size_t)TP * 1024;
        float sv[8];
#pragma unroll
        for (int ai = 0; ai < 2; ++ai)
#pragma unroll
            for (int m = 0; m < 4; ++m) { const int row = r0 + ai * 128 + m * 16; float s = 0.f;
#pragma unroll
                for (int bj = 0; bj < 2; ++bj) { const size_t off = (size_t)row * 1024 + c0 + bj * 128;
                    f32x4 v0, v1;
                    if (MODE == 0) { v0 = *(const f32x4*)(xo + off); v1 = *(const f32x4*)(xo + off + 4); }
                    else { const u32x4 w = *(const u32x4*)(xb + off); v0 = (f32x4){bflo(w.x), bfhi(w.x), bflo(w.y), bfhi(w.y)}; v1 = (f32x4){bflo(w.z), bfhi(w.z), bflo(w.w), bfhi(w.w)}; }
                    v0 += acc[ai][bj][m][0]; v1 += acc[ai][bj][m][1];
                    if (MODE == 2) { *(f32x4*)(out + off) = v0; *(f32x4*)(out + off + 4) = v1; } else st_bf16x8(xb + off, v0, v1);
                    s += v0[0] * v0[0] + v0[1] * v0[1] + v0[2] * v0[2] + v0[3] * v0[3] + v1[0] * v1[0] + v1[1] * v1[1] + v1[2] * v1[2] + v1[3] * v1[3]; }
                sv[ai * 4 + m] = s; }
        row_allreduce<false>(sv, st, wr, wc, fr, fq);
        if (fq == 0 && wc == 0) {
#pragma unroll
            for (int i = 0; i < 8; ++i) ssout[(size_t)(u.col0 >> 8) * T + r0 + (i >> 2) * 128 + (i & 3) * 16] = sv[i]; }
    } };
struct EpiSoftmax { bf16_t* P; const float* ss;
    DI void operator()(Acc& acc, const Unit& u, int wr, int wc, int fr, int fq, LAS float* st) const {
        const int r0 = u.row0 + wr * 64 + fr, c0 = u.col0 + wc * 32 + 8 * fq;
        float mx[8], sm[8];
#pragma unroll
        for (int i = 0; i < 8; ++i) { const int ai = i >> 2, m = i & 3; const float sc = rstd4(ss, r0 + ai * 128 + m * 16) * 1.4426950408889634f; float x = -3.0e38f;
#pragma unroll
            for (int bj = 0; bj < 2; ++bj)
#pragma unroll
                for (int n = 0; n < 2; ++n) { acc[ai][bj][m][n] *= sc;
#pragma unroll
                    for (int k = 0; k < 4; ++k) x = fmaxf(x, acc[ai][bj][m][n][k]); }
            mx[i] = x; }
        row_allreduce<true>(mx, st, wr, wc, fr, fq);
#pragma unroll
        for (int i = 0; i < 8; ++i) { const int ai = i >> 2, m = i & 3; float s = 0.f;
#pragma unroll
            for (int bj = 0; bj < 2; ++bj)
#pragma unroll
                for (int n = 0; n < 2; ++n)
#pragma unroll
                    for (int k = 0; k < 4; ++k) { const float e = __builtin_amdgcn_exp2f(acc[ai][bj][m][n][k] - mx[i]); acc[ai][bj][m][n][k] = e; s += e; }
            sm[i] = s; }
        row_allreduce<false>(sm, st + 1024, wr, wc, fr, fq);
#pragma unroll
        for (int i = 0; i < 8; ++i) { const int ai = i >> 2, m = i & 3, row = r0 + ai * 128 + m * 16; const float inv = 1.0f / sm[i];
#pragma unroll
            for (int bj = 0; bj < 2; ++bj) st_bf16x8(P + (size_t)row * 1024 + c0 + bj * 128, acc[ai][bj][m][0] * inv, acc[ai][bj][m][1] * inv); }
    } };
struct EpiSqRelu { bf16_t* O; int ldc; const float* ss; int rowbase;
    DI void operator()(const Acc& acc, const Unit& u, int wr, int wc, int fr, int fq, LAS float*) const {
        const int r0 = u.row0 + wr * 64 + fr, c0 = u.col0 + wc * 32 + 8 * fq;
#pragma unroll
        for (int ai = 0; ai < 2; ++ai)
#pragma unroll
            for (int m = 0; m < 4; ++m) { const int row = r0 + ai * 128 + m * 16; const float sc = rstd4(ss, row);
                bf16_t* rp = O + (size_t)(row - rowbase) * ldc + c0;
#pragma unroll
                for (int bj = 0; bj < 2; ++bj) { f32x4 v0 = acc[ai][bj][m][0] * sc, v1 = acc[ai][bj][m][1] * sc;
#pragma unroll
                    for (int k = 0; k < 4; ++k) { const float a = fmaxf(v0[k], 0.f), b = fmaxf(v1[k], 0.f); v0[k] = a * a; v1[k] = b * b; }
                    st_bf16x8(rp + bj * 128, v0, v1); } }
    } };

template <class Epi, class SchedT>
__device__ __forceinline__ void gemm_phase(LAS unsigned char* lds, int K, int lda, int ldb, const SchedT& S, const Epi& E, int wv) {
    int tid = tid_of(wv); asm volatile("" : "+v"(tid));
    const int wid = __builtin_amdgcn_readfirstlane(tid >> 6), lane = tid & 63, wr = wid >> 2, wc = wid & 3, fr = lane & 15, fq = lane >> 4;
    const int nt = K / BK;
    LAS float* stats = (LAS float*)(lds + STAGE_BYTES);
    unsigned voffA[2], voffB[2];
#pragma unroll
    for (int i = 0; i < 2; ++i) { int R, C; stage_rc(tid * 16 + i * 8192, R, C); const int Rb = (R & ~31) + perm32(R & 31);
        voffA[i] = (unsigned)(R * lda + C) * 2u; voffB[i] = (unsigned)(Rb * ldb + C) * 2u; }
    const size_t kstep = (size_t)(BK * 2);
    const size_t hstepA = (size_t)HALF * lda * 2, hstepB = (size_t)HALF * ldb * 2;
    const unsigned ldsw = (unsigned)wid * 1024u;
    const int aoff = lds_byte(wr * 64 + fr, fq * 8), boff = lds_byte(wc * 32 + fr, fq * 8);
#define PG8_SA(b, h) (((b) * 2 + (h)) * HTB)
#define PG8_SB(b, h) ((4 + (b) * 2 + (h)) * HTB)
#define PG8_STAGE(bufoff, gbase, voff) do { _Pragma("unroll") for (int _i = 0; _i < 2; ++_i) \
        __builtin_amdgcn_global_load_lds((const unsigned*)((const char*)(gbase) + (voff)[_i]), (LAS unsigned*)(lds + (bufoff) + ldsw + _i * 8192), 16, 0, 0); } while (0)
#define PG8_LDA(dst, b, h) do { _Pragma("unroll") for (int m = 0; m < 4; ++m) _Pragma("unroll") for (int k = 0; k < 2; ++k) dst[m][k] = *(const LAS bf16x8*)(lds + PG8_SA(b, h) + aoff + m * 2048 + k * 1024); } while (0)
#define PG8_LDB(dst, b, h) do { _Pragma("unroll") for (int n = 0; n < 2; ++n) _Pragma("unroll") for (int k = 0; k < 2; ++k) dst[n][k] = *(const LAS bf16x8*)(lds + PG8_SB(b, h) + boff + n * 2048 + k * 1024); } while (0)
#define PG8_MMA(ai, bj, At, Bt) do { __builtin_amdgcn_s_setprio(1); _Pragma("unroll") for (int m = 0; m < 4; ++m) _Pragma("unroll") for (int n = 0; n < 2; ++n) _Pragma("unroll") for (int k = 0; k < 2; ++k) \
        acc[ai][bj][m][n] = __builtin_amdgcn_mfma_f32_16x16x32_bf16(Bt[n][k], At[m][k], acc[ai][bj][m][n], 0, 0, 0); __builtin_amdgcn_s_setprio(0); } while (0)
#define PG8_WAIT_V(n) asm volatile("s_waitcnt vmcnt(" #n ")" ::: "memory")
#define PG8_WAIT_L(n) asm volatile("s_waitcnt lgkmcnt(" #n ")" ::: "memory")
#define PG8_BAR __builtin_amdgcn_s_barrier()
#define PG8_SCHED __builtin_amdgcn_sched_barrier(0)
    Unit cur, nxt; int ui = 0;
    if (!S.next(0, cur)) return;
    Acc acc;
#pragma unroll
    for (int a = 0; a < 2; ++a)
#pragma unroll
        for (int b = 0; b < 2; ++b)
#pragma unroll
            for (int m = 0; m < 4; ++m)
#pragma unroll
                for (int n = 0; n < 2; ++n) acc[a][b][m][n] = (f32x4){0.f, 0.f, 0.f, 0.f};
    bf16x8 At[4][2], B0[2][2], B1[2][2];
    const char* cA = cur.A; const char* cB = cur.B;
    PG8_STAGE(PG8_SB(0, 0), cB, voffB); PG8_STAGE(PG8_SA(0, 0), cA, voffA); PG8_STAGE(PG8_SB(0, 1), cB + hstepB, voffB); PG8_STAGE(PG8_SA(0, 1), cA + hstepA, voffA);
    if (wr == 1) PG8_BAR;
    PG8_WAIT_V(4); PG8_BAR;
    PG8_STAGE(PG8_SB(1, 0), cB + kstep, voffB); PG8_STAGE(PG8_SA(1, 0), cA + kstep, voffA); PG8_STAGE(PG8_SB(1, 1), cB + hstepB + kstep, voffB);
    PG8_WAIT_V(6); PG8_BAR;
    for (;;) {
        const bool has_next = S.next(ui + 1, nxt);
        const char* nA = has_next ? nxt.A : cA; const char* nB = has_next ? nxt.B : cB;
        for (int t = 0; t < nt; t += 2) {
            const bool last = (t == nt - 2);
            const char* a1 = cA + (size_t)(t + 1) * kstep;
            const char* a2 = last ? nA : cA + (size_t)(t + 2) * kstep; const char* b2 = last ? nB : cB + (size_t)(t + 2) * kstep;
            const char* a3 = a2 + kstep; const char* b3 = b2 + kstep;
            PG8_LDB(B0, 0, 0); PG8_SCHED; PG8_LDA(At, 0, 0); PG8_STAGE(PG8_SA(1, 1), a1 + hstepA, voffA);
            PG8_WAIT_L(8); PG8_BAR; PG8_WAIT_L(0); PG8_MMA(0, 0, At, B0); PG8_BAR; PG8_SCHED;
            PG8_LDB(B1, 0, 1); PG8_STAGE(PG8_SB(0, 0), b2, voffB);
            PG8_BAR; PG8_WAIT_L(0); PG8_MMA(0, 1, At, B1); PG8_BAR;
            PG8_LDA(At, 0, 1); PG8_STAGE(PG8_SA(0, 0), a2, voffA);
            PG8_BAR; PG8_WAIT_L(0); PG8_MMA(1, 0, At, B0); PG8_BAR; PG8_SCHED;
            PG8_STAGE(PG8_SB(0, 1), b2 + hstepB, voffB);
            PG8_WAIT_V(6); PG8_BAR; PG8_MMA(1, 1, At, B1); PG8_BAR;
            PG8_LDB(B0, 1, 0); PG8_SCHED; PG8_LDA(At, 1, 0); PG8_STAGE(PG8_SA(0, 1), a2 + hstepA, voffA);
            PG8_WAIT_L(8); PG8_BAR; PG8_WAIT_L(0); PG8_MMA(0, 0, At, B0); PG8_BAR; PG8_SCHED;
            PG8_LDB(B1, 1, 1); PG8_STAGE(PG8_SB(1, 0), b3, voffB);
            PG8_BAR; PG8_WAIT_L(0); PG8_MMA(0, 1, At, B1); PG8_BAR;
            PG8_LDA(At, 1, 1); PG8_STAGE(PG8_SA(1, 0), a3, voffA);
            PG8_BAR; PG8_WAIT_L(0); PG8_MMA(1, 0, At, B0); PG8_BAR; PG8_SCHED;
            PG8_STAGE(PG8_SB(1, 1), b3 + hstepB, voffB);
            PG8_WAIT_V(6); PG8_BAR; PG8_MMA(1, 1, At, B1); PG8_BAR;
        }
        E(acc, cur, wr, wc, fr, fq, stats);
        if (!has_next) break;
#pragma unroll
        for (int a = 0; a < 2; ++a)
#pragma unroll
            for (int b = 0; b < 2; ++b)
#pragma unroll
                for (int m = 0; m < 4; ++m)
#pragma unroll
                    for (int n = 0; n < 2; ++n) acc[a][b][m][n] = (f32x4){0.f, 0.f, 0.f, 0.f};
        cur = nxt; cA = nA; cB = nB; ++ui;
    }
    PG8_WAIT_V(0);
    if (wr == 0) PG8_BAR;
    PG8_BAR;
#undef PG8_SA
#undef PG8_SB
#undef PG8_STAGE
#undef PG8_LDA
#undef PG8_LDB
#undef PG8_MMA
#undef PG8_WAIT_V
#undef PG8_WAIT_L
#undef PG8_BAR
#undef PG8_SCHED
}
}

struct CvtJob { const float* src; int lds_src, col0, K, N, nvalid; const float* g; bf16_t* dst; int ldd; int sn0, sn1; float sscale; };
DI void cvt_tile(const CvtJob& J, int tile, LAS float* tl, int wv) {
    const int tid = tid_of(wv), nkt = J.K / 64, kt = tile % nkt, ntile = tile / nkt, k0 = kt * 64, n0 = ntile * 64;
    { const int kr = tid >> 4, nc = (tid & 15) * 4;
#pragma unroll
      for (int i = 0; i < 2; ++i) { const int k = k0 + kr + 32 * i; f32x4 v = (f32x4){0.f, 0.f, 0.f, 0.f};
          if (n0 + nc < J.nvalid) v = *(const f32x4*)(J.src + (size_t)k * J.lds_src + J.col0 + n0 + nc);
          float s = J.g ? J.g[k] : 1.0f; if (n0 + nc >= J.sn0 && n0 + nc < J.sn1) s *= J.sscale;
#pragma unroll
          for (int j = 0; j < 4; ++j) tl[(kr + 32 * i) * 65 + nc + j] = v[j] * s; } }
    __syncthreads();
    { const int n = tid >> 3, kq = (tid & 7) * 8; float v[8];
#pragma unroll
      for (int j = 0; j < 8; ++j) v[j] = tl[(kq + j) * 65 + n];
      pg8::st_bf16x8(J.dst + (size_t)(n0 + n) * J.ldd + k0 + kq, (f32x4){v[0], v[1], v[2], v[3]}, (f32x4){v[4], v[5], v[6], v[7]}); }
    __syncthreads();
}
DI int cvt_tiles(const CvtJob& J) { return (J.K / 64) * (J.N / 64); }

DI void rows_to_bf16(const float* xlo, const float* xhi, int nrows, int split, bf16_t* dst, float* ss, int gw, int nw, bool slots4) {
    const int lane = lane_id();
    for (int row = gw; row < nrows; row += nw) {
        const float* src = (row < split) ? xlo + (size_t)row * 1024 : xhi + (size_t)(row - split) * 1024;
        float s = 0.f;
#pragma unroll
        for (int i = 0; i < 4; ++i) { const f32x4 v = *(const f32x4*)(src + i * 256 + lane * 4);
            s += v[0] * v[0] + v[1] * v[1] + v[2] * v[2] + v[3] * v[3];
            u32x2 w; w.x = cvt_pk_bf16(v[0], v[1]); w.y = cvt_pk_bf16(v[2], v[3]); *(u32x2*)(dst + (size_t)row * 1024 + i * 256 + lane * 4) = w; }
        if (ss) {
#pragma unroll
            for (int o = 32; o >= 1; o >>= 1) s += __shfl_xor(s, o);
            if (lane == 0) { ss[row] = s; if (slots4) { ss[T + row] = 0.f; ss[2 * T + row] = 0.f; ss[3 * T + row] = 0.f; } } }
    }
}
DI int rel_bucket(int rp) {
    const int ret = rp > 0 ? 16 : 0; const int n = rp < 0 ? -rp : rp; const float nf = (float)(n > 1 ? n : 1);
    int large = 8 + (int)(logf(nf / 8.0f) / 2.772588722239781f * 8.0f); large = large < 15 ? large : 15;
    return ret + (n < 8 ? n : large);
}

namespace scan {
constexpr int LD = 136;
constexpr int O_Q = 0, O_K = 34816, O_KT = 69632, O_VT = 104448, O_CT = 121856, O_F = 139264;
DI bf16x8 rev8(bf16x8 v) { return (bf16x8){v[7], v[6], v[5], v[4], v[3], v[2], v[1], v[0]}; }
#define MFMA16(a, b, c) __builtin_amdgcn_mfma_f32_16x16x32_bf16((a), (b), (c), 0, 0, 0)

__device__ __forceinline__ void run(const Params& p, LAS unsigned char* lds, int item, int wv) {
    int tid = tid_of(wv); asm volatile("" : "+v"(tid));
    const int wid = __builtin_amdgcn_readfirstlane(tid >> 6), lane = tid & 63, fr = lane & 15, fq = lane >> 4;
    const int seq = item >> 5, rem = item & 31, h = rem >> 3, dir = (rem >> 2) & 1, slice = rem & 3;
    const int S = seq < 2 ? 16384 : 8192, seq0 = seq < 2 ? seq * 16384 : TP + (seq - 2) * 8192, nc = S / 128;
    const bf16_t* Qg = (const bf16_t*)(p.ws + O_R1) + (size_t)h * T * 128;
    const bf16_t* Kg = (const bf16_t*)(p.ws + O_R1 + 64 * MiB) + (size_t)h * T * 128;
    const bf16_t* KTg = (const bf16_t*)p.out + (size_t)(h * 128) * 128;
    const bf16_t* VTg = (const bf16_t*)p.out + (size_t)(512 + h * 256 + slice * 64) * 128;
    const float* gates = (const float*)(p.ws + O_GATES);
    bf16_t* Hg = (bf16_t*)(p.ws + (dir ? O_R0 : O_R2)) + h * 256 + slice * 64;
    LAS bf16_t* sQ = (LAS bf16_t*)(lds + O_Q); LAS bf16_t* sK = (LAS bf16_t*)(lds + O_K); LAS bf16_t* sKt = (LAS bf16_t*)(lds + O_KT);
    LAS bf16_t* sVt = (LAS bf16_t*)(lds + O_VT); LAS bf16_t* sCt = (LAS bf16_t*)(lds + O_CT);
    LAS float* F = (LAS float*)(lds + O_F);
    LAS float *gA = F, *MA = F + 128, *iwA = F + 256, *emA = F + 384, *wA = F + 512, *qnA = F + 640, *nvA = F + 768, *dinvA = F + 896, *rawig = F + 1024, *rawlf = F + 1152, *denp = F + 1280, *scal = F + 1792;
    for (int i = tid; i < 64 * LD / 2; i += NTHREADS) ((LAS unsigned*)sCt)[i] = 0u;
    if (tid < 128) nvA[tid] = 0.f;
    float m_state = 0.f;
    f32x4 cacc[2][2];
#pragma unroll
    for (int a = 0; a < 2; ++a)
#pragma unroll
        for (int b = 0; b < 2; ++b) cacc[a][b] = (f32x4){0.f, 0.f, 0.f, 0.f};
    bf16x8 pq[4], pk[4], pkt[4], pvt[2]; float pig = 0.f, plf = 0.f;
    const int igc = dir * 8 + h, lfc = dir * 8 + 4 + h;
#define SC_PREFETCH(cc) do { const int base = seq0 + (dir ? S - 128 - (cc) * 128 : (cc) * 128); \
        _Pragma("unroll") for (int k = 0; k < 4; ++k) { const int pp = tid + 512 * k, r = pp >> 4, c8 = (pp & 15) * 8; const size_t tok = (size_t)(base + (dir ? 127 - r : r)); \
            pq[k] = *(const bf16x8*)(Qg + tok * 128 + c8); pk[k] = *(const bf16x8*)(Kg + tok * 128 + c8); \
            pkt[k] = *(const bf16x8*)(KTg + ((size_t)(base >> 7) * 1536 + r) * 128 + (dir ? 120 - c8 : c8)); } \
        _Pragma("unroll") for (int k = 0; k < 2; ++k) { const int pp = tid + 512 * k, r = pp >> 4, c8 = (pp & 15) * 8; \
            pvt[k] = *(const bf16x8*)(VTg + ((size_t)(base >> 7) * 1536 + r) * 128 + (dir ? 120 - c8 : c8)); } \
        if (tid < 128) { const size_t tok = (size_t)(base + (dir ? 127 - tid : tid)); pig = gates[tok * 16 + igc]; plf = gates[tok * 16 + lfc]; } } while (0)
    SC_PREFETCH(0);
    for (int cc = 0; cc < nc; ++cc) {
        const int base = seq0 + (dir ? S - 128 - cc * 128 : cc * 128);
        if (tid < 128) { rawig[tid] = pig; rawlf[tid] = plf; }
        __syncthreads();
        if (wid == 0) {
            const float x0 = rawlf[2 * lane], x1 = rawlf[2 * lane + 1], i0 = rawig[2 * lane], i1 = rawig[2 * lane + 1];
            const float s = x0 + x1; float incl = s;
#pragma unroll
            for (int o = 1; o < 64; o <<= 1) { const float t = __shfl_up(incl, o); if (lane >= o) incl += t; }
            const float b0 = incl - s + x0, b1 = incl;
            const float g0 = i0 - b0, g1 = i1 - b1; float im = fmaxf(g0, g1);
#pragma unroll
            for (int o = 1; o < 64; o <<= 1) { const float t = __shfl_up(im, o); if (lane >= o) im = fmaxf(im, t); }
            float em_ = __shfl_up(im, 1); if (lane == 0) em_ = -3.0e38f;
            const float M0 = fmaxf(m_state, fmaxf(em_, g0)), M1 = fmaxf(m_state, im);
            const float Ml = __shfl(M1, 63), bl = __shfl(b1, 63);
            gA[2 * lane] = g0; gA[2 * lane + 1] = g1; MA[2 * lane] = M0; MA[2 * lane + 1] = M1;
            iwA[2 * lane] = __expf(m_state - M0); iwA[2 * lane + 1] = __expf(m_state - M1);
            emA[2 * lane] = __expf(-(b0 + M0)); emA[2 * lane + 1] = __expf(-(b1 + M1));
            wA[2 * lane] = __expf(g0 - Ml); wA[2 * lane + 1] = __expf(g1 - Ml);
            if (lane == 0) scal[0] = __expf(m_state - Ml);
            m_state = bl + Ml;
        }
        __syncthreads();
#pragma unroll
        for (int k = 0; k < 4; ++k) { const int pp = tid + 512 * k, r = pp >> 4, c8 = (pp & 15) * 8;
            *(LAS bf16x8*)(sQ + r * LD + c8) = pq[k]; *(LAS bf16x8*)(sK + r * LD + c8) = pk[k];
            bf16x8 v = dir ? rev8(pkt[k]) : pkt[k]; const f32x4 w0 = *(const LAS f32x4*)(wA + c8), w1 = *(const LAS f32x4*)(wA + c8 + 4);
            u32x4 o; o.x = cvt_pk_bf16(bflo((unsigned)(unsigned short)v[0]) * w0[0], bflo((unsigned)(unsigned short)v[1]) * w0[1]);
            o.y = cvt_pk_bf16(bflo((unsigned)(unsigned short)v[2]) * w0[2], bflo((unsigned)(unsigned short)v[3]) * w0[3]);
            o.z = cvt_pk_bf16(bflo((unsigned)(unsigned short)v[4]) * w1[0], bflo((unsigned)(unsigned short)v[5]) * w1[1]);
            o.w = cvt_pk_bf16(bflo((unsigned)(unsigned short)v[6]) * w1[2], bflo((unsigned)(unsigned short)v[7]) * w1[3]);
            *(LAS u32x4*)(sKt + r * LD + c8) = o; }
#pragma unroll
        for (int k = 0; k < 2; ++k) { const int pp = tid + 512 * k, r = pp >> 4, c8 = (pp & 15) * 8; *(LAS bf16x8*)(sVt + r * LD + c8) = dir ? rev8(pvt[k]) : pvt[k]; }
        __syncthreads();
        const int sblk = (wid & 3) * 32, tblk = (wid >> 2) * 64, tb = (wid & 3) * 32, eb = (wid >> 2) * 32;
        f32x4 sacc[2][4], nacc[2][2];
#pragma unroll
        for (int a = 0; a < 2; ++a) {
#pragma unroll
            for (int b = 0; b < 4; ++b) sacc[a][b] = (f32x4){0.f, 0.f, 0.f, 0.f};
#pragma unroll
            for (int b = 0; b < 2; ++b) nacc[a][b] = (f32x4){0.f, 0.f, 0.f, 0.f}; }
#pragma unroll 1
        for (int kk = 0; kk < 4; ++kk) { const int ko = kk * 32 + fq * 8;
            bf16x8 ka[2], qb[4], qa[2], cb[2];
#pragma unroll
            for (int a = 0; a < 2; ++a) { ka[a] = *(const LAS bf16x8*)(sK + (sblk + a * 16 + fr) * LD + ko); qa[a] = *(const LAS bf16x8*)(sQ + (tb + a * 16 + fr) * LD + ko); cb[a] = *(const LAS bf16x8*)(sCt + (eb + a * 16 + fr) * LD + ko); }
#pragma unroll
            for (int b = 0; b < 4; ++b) qb[b] = *(const LAS bf16x8*)(sQ + (tblk + b * 16 + fr) * LD + ko);
#pragma unroll
            for (int a = 0; a < 2; ++a) {
#pragma unroll
                for (int b = 0; b < 4; ++b) sacc[a][b] = MFMA16(ka[a], qb[b], sacc[a][b]);
#pragma unroll
                for (int b = 0; b < 2; ++b) nacc[a][b] = MFMA16(qa[a], cb[b], nacc[a][b]); } }
        { const int t = tid >> 2, part = tid & 3; float s = 0.f;
#pragma unroll
          for (int k = 0; k < 4; ++k) { const u32x4 qv = *(const LAS u32x4*)(sQ + t * LD + part * 32 + k * 8); const f32x4 n0 = *(const LAS f32x4*)(nvA + part * 32 + k * 8), n1 = *(const LAS f32x4*)(nvA + part * 32 + k * 8 + 4);
              s += bflo(qv.x) * n0[0] + bfhi(qv.x) * n0[1] + bflo(qv.y) * n0[2] + bfhi(qv.y) * n0[3] + bflo(qv.z) * n1[0] + bfhi(qv.z) * n1[1] + bflo(qv.w) * n1[2] + bfhi(qv.w) * n1[3]; }
          s += __shfl_xor(s, 1); s += __shfl_xor(s, 2); if (part == 0) qnA[t] = s; }
        if (cc + 1 < nc) SC_PREFETCH(cc + 1);
        {
            float gv[2][4];
#pragma unroll
            for (int a = 0; a < 2; ++a) { const f32x4 x = *(const LAS f32x4*)(gA + sblk + a * 16 + 4 * fq); gv[a][0] = x[0]; gv[a][1] = x[1]; gv[a][2] = x[2]; gv[a][3] = x[3]; }
#pragma unroll
            for (int b = 0; b < 4; ++b) { const int t = tblk + b * 16 + fr; const float Mt = MA[t]; float rs = 0.f;
#pragma unroll
                for (int a = 0; a < 2; ++a)
#pragma unroll
                    for (int r = 0; r < 4; ++r) { const int sp = sblk + a * 16 + 4 * fq + r; const float e = (sp <= t) ? __expf(gv[a][r] - Mt) : 0.f; const float pv = sacc[a][b][r] * e; sacc[a][b][r] = pv; rs += pv; }
                rs += __shfl_xor(rs, 16); rs += __shfl_xor(rs, 32);
                if (fq == 0) denp[(wid & 3) * 128 + t] = rs; }
        }
        __syncthreads();
#pragma unroll
        for (int a = 0; a < 2; ++a)
#pragma unroll
            for (int b = 0; b < 4; ++b) { u32x2 w; w.x = cvt_pk_bf16(sacc[a][b][0], sacc[a][b][1]); w.y = cvt_pk_bf16(sacc[a][b][2], sacc[a][b][3]);
                *(LAS u32x2*)(sK + (tblk + b * 16 + fr) * LD + sblk + a * 16 + 4 * fq) = w; }
        if (tid < 128) { const float den = iwA[tid] * qnA[tid] + ((denp[tid] + denp[128 + tid]) + (denp[256 + tid] + denp[384 + tid])); dinvA[tid] = 1.0f / fmaxf(fabsf(den), emA[tid]); }
        __syncthreads();
#pragma unroll
        for (int a = 0; a < 2; ++a) { const f32x4 iw = *(const LAS f32x4*)(iwA + tb + a * 16 + 4 * fq);
#pragma unroll
            for (int b = 0; b < 2; ++b) nacc[a][b] *= iw; }
        const float decay = scal[0];
#pragma unroll
        for (int a = 0; a < 2; ++a)
#pragma unroll
            for (int b = 0; b < 2; ++b) cacc[a][b] *= decay;
#pragma unroll 1
        for (int kk = 0; kk < 4; ++kk) { const int ko = kk * 32 + fq * 8;
            bf16x8 pa[2], vb[2], kta[2];
#pragma unroll
            for (int a = 0; a < 2; ++a) { pa[a] = *(const LAS bf16x8*)(sK + (tb + a * 16 + fr) * LD + ko); vb[a] = *(const LAS bf16x8*)(sVt + (eb + a * 16 + fr) * LD + ko); kta[a] = *(const LAS bf16x8*)(sKt + (tb + a * 16 + fr) * LD + ko); }
#pragma unroll
            for (int a = 0; a < 2; ++a)
#pragma unroll
                for (int b = 0; b < 2; ++b) { nacc[a][b] = MFMA16(pa[a], vb[b], nacc[a][b]); cacc[a][b] = MFMA16(kta[a], vb[b], cacc[a][b]); } }
        float nsum;
        { const int d = tid >> 2, part = tid & 3; float s = 0.f;
#pragma unroll
          for (int k = 0; k < 4; ++k) { const u32x4 kv = *(const LAS u32x4*)(sKt + d * LD + part * 32 + k * 8);
              s += (bflo(kv.x) + bfhi(kv.x)) + (bflo(kv.y) + bfhi(kv.y)) + (bflo(kv.z) + bfhi(kv.z)) + (bflo(kv.w) + bfhi(kv.w)); }
          s += __shfl_xor(s, 1); s += __shfl_xor(s, 2); nsum = s; }
#pragma unroll
        for (int a = 0; a < 2; ++a) { const f32x4 di = *(const LAS f32x4*)(dinvA + tb + a * 16 + 4 * fq);
#pragma unroll
            for (int r = 0; r < 4; ++r) { const int t = tb + a * 16 + 4 * fq + r; const size_t tok = (size_t)(base + (dir ? 127 - t : t));
#pragma unroll
                for (int b = 0; b < 2; ++b) { const float hv = nacc[a][b][r] * di[r]; Hg[tok * 1024 + eb + b * 16 + fr] = (bf16_t)(cvt_pk_bf16(hv, hv) & 0xffffu); } } }
        __syncthreads();
#pragma unroll
        for (int a = 0; a < 2; ++a)
#pragma unroll
            for (int b = 0; b < 2; ++b) { u32x2 w; w.x = cvt_pk_bf16(cacc[a][b][0], cacc[a][b][1]); w.y = cvt_pk_bf16(cacc[a][b][2], cacc[a][b][3]);
                *(LAS u32x2*)(sCt + (eb + b * 16 + fr) * LD + tb + a * 16 + 4 * fq) = w; }
        if ((tid & 3) == 0) nvA[tid >> 2] = decay * nvA[tid >> 2] + nsum;
    }
    __syncthreads();
#undef SC_PREFETCH
}
}

namespace dattn {
constexpr int KVBLK = 64;
constexpr float SCALE = 0.125f;
constexpr float THR = 8.f;
constexpr int LDQ = 128, LDK = 128;
constexpr size_t SHM_V = KVBLK * 128 * 2, SHM_K = KVBLK * 128 * 2;
constexpr int O_WS = 2 * SHM_V + 2 * SHM_K;
constexpr int O_LUT = O_WS + 8 * 64 * 4;
#define KSWZ(row, colB) ((row) * 256 + ((colB) ^ (((row) & 7) << 4)))
#define SBAR() __builtin_amdgcn_sched_barrier(0)
DI int crow(int r, int hi) { return (r & 3) + 8 * (r >> 2) + 4 * hi; }
DI unsigned cvtpk(float lo, float hi) { unsigned r; asm volatile("v_cvt_pk_bf16_f32 %0, %1, %2" : "=v"(r) : "v"(lo), "v"(hi)); return r; }

DI void partialSM(f32x16& p0, f32x16& p1, float& m_reg, float& mn, float& alpha, float cadd) {
    constexpr float C = SCALE * 1.4426950408889634f;
    float pmax = p0[0];
#pragma unroll
    for (int r = 1; r < 16; ++r) pmax = fmaxf(pmax, p0[r]);
#pragma unroll
    for (int r = 0; r < 16; ++r) pmax = fmaxf(pmax, p1[r]);
    { auto rr = __builtin_amdgcn_permlane32_swap(__float_as_uint(pmax), __float_as_uint(pmax), false, false);
      pmax = fmaxf(__uint_as_float(rr[0]), __uint_as_float(rr[1])) + cadd; }
    if (__builtin_expect(__all(pmax - m_reg <= THR / SCALE), 1)) { mn = m_reg; alpha = 1.f; }
    else { mn = fmaxf(m_reg, pmax); alpha = __builtin_amdgcn_exp2f((m_reg - mn) * C); m_reg = mn; }
    const float mnC = (cadd - mn) * C;
#pragma unroll
    for (int r = 0; r < 16; ++r) p0[r] = fmaf(p0[r], C, mnC);
#pragma unroll
    for (int r = 0; r < 16; ++r) p1[r] = fmaf(p1[r], C, mnC);
#pragma unroll
    for (int r = 0; r < 16; ++r) p0[r] = __builtin_amdgcn_exp2f(p0[r]);
}
constexpr float THRL = 11.5415603f;
DI void partialSM4(f32x16& p0, f32x16& p1, float& m_reg, float& alpha, bool first) {
    float pmax = p0[0];
#pragma unroll
    for (int r = 1; r < 16; ++r) pmax = fmaxf(pmax, p0[r]);
#pragma unroll
    for (int r = 0; r < 16; ++r) pmax = fmaxf(pmax, p1[r]);
    { auto rr = __builtin_amdgcn_permlane32_swap(__float_as_uint(pmax), __float_as_uint(pmax), false, false);
      pmax = fmaxf(__uint_as_float(rr[0]), __uint_as_float(rr[1])); }
    const float delta = first ? pmax : (pmax <= THRL ? 0.f : pmax);
    alpha = 1.f;
    if (__builtin_expect(!__all(delta == 0.f), 0)) {
        if (!first) alpha = __builtin_amdgcn_exp2f(-delta);
        m_reg += delta;
#pragma unroll
        for (int r = 0; r < 16; ++r) { p0[r] -= delta; p1[r] -= delta; }
    }
#pragma unroll
    for (int r = 0; r < 16; ++r) p0[r] = __builtin_amdgcn_exp2f(p0[r]);
}
DI void finishSM(f32x16& p0, f32x16& p1, float alpha, float& l_reg, bf16x8& pa0, bf16x8& pa1, bf16x8& pa2, bf16x8& pa3) {
#pragma unroll
    for (int r = 0; r < 16; ++r) p1[r] = __builtin_amdgcn_exp2f(p1[r]);
    float ps = 0;
#pragma unroll
    for (int r = 0; r < 16; ++r) ps += p0[r];
#pragma unroll
    for (int r = 0; r < 16; ++r) ps += p1[r];
    { auto rr = __builtin_amdgcn_permlane32_swap(__float_as_uint(ps), __float_as_uint(ps), false, false);
      ps = __uint_as_float(rr[0]) + __uint_as_float(rr[1]); }
    l_reg = l_reg * alpha + ps;
#define PK4(P, BASE, OUT) do { unsigned a0 = cvtpk(P[BASE + 0], P[BASE + 1]), a1 = cvtpk(P[BASE + 2], P[BASE + 3]);   \
    unsigned b0 = cvtpk(P[BASE + 4], P[BASE + 5]), b1 = cvtpk(P[BASE + 6], P[BASE + 7]);                              \
    auto r0 = __builtin_amdgcn_permlane32_swap(a0, b0, false, false); auto r1 = __builtin_amdgcn_permlane32_swap(a1, b1, false, false); \
    u32x4 w = {r0[0], r1[0], r0[1], r1[1]}; OUT = *reinterpret_cast<bf16x8*>(&w); } while (0)
    PK4(p0, 0, pa0); PK4(p0, 8, pa1); PK4(p1, 0, pa2); PK4(p1, 8, pa3);
#undef PK4
}
DI void qkt(f32x16& p0, f32x16& p1, const char* Ks, const bf16x8* qr, int r32, int hi, int map, const f32x16& cinit = f32x16{}) {
    p0 = cinit; p1 = cinit;
#pragma unroll
    for (int d0 = 0; d0 < 4; ++d0) { const int cb = ((map * 4 + d0) * 16 + hi * 8) * 2;
        const bf16x8 b0 = *reinterpret_cast<const bf16x8*>(Ks + KSWZ(r32, cb));
        const bf16x8 b1 = *reinterpret_cast<const bf16x8*>(Ks + KSWZ(32 + r32, cb));
        p0 = __builtin_amdgcn_mfma_f32_32x32x16_bf16(b0, qr[d0], p0, 0, 0, 0);
        p1 = __builtin_amdgcn_mfma_f32_32x32x16_bf16(b1, qr[d0], p1, 0, 0, 0); }
}
DI void add_bias_near(f32x16& p0, f32x16& p1, int kq, const float* lut) {
    asm volatile("" : "+v"(kq));
#pragma unroll
    for (int r = 0; r < 16; ++r) { const int k0 = kq + (r & 3) + 8 * (r >> 2); const int i0 = k0 < -128 ? -128 : (k0 > 128 ? 128 : k0); const int k1 = k0 + 32; const int i1 = k1 < -128 ? -128 : (k1 > 128 ? 128 : k1);
        p0[r] += lut[i0 + 128]; p1[r] += lut[i1 + 128]; }
}
DI int v_st(int k, int c) { const int kk = (k & ~0xC) | ((k & 4) << 1) | ((k & 8) >> 1); return ((kk >> 3) * 4 + (c >> 5)) * 512 + ((kk & 7) * 32 + (c & 31)) * 2; }
DI int v_rd_base(int lane) { return ((lane & 3) << 3) | (((lane >> 2) & 3) << 6) | (((lane >> 4) & 1) << 5) | (((lane >> 5) & 1) << 8); }
constexpr int v_rd_off(int d0, int ks, int half) { return d0 * 512 + ks * 4096 + half * 2048; }
template <int OFF> DI s16x4 tr_read(int vb) { s16x4 r; asm volatile("ds_read_b64_tr_b16 %0, %1 offset:%2" : "=&v"(r) : "v"(vb), "i"(OFF) : "memory"); return r; }
template <int D0> DI void pv_one(f32x16& od, int vb, bf16x8 pa0, bf16x8 pa1, bf16x8 pa2, bf16x8 pa3) {
    const s16x4 l0 = tr_read<v_rd_off(D0, 0, 0)>(vb), h0 = tr_read<v_rd_off(D0, 0, 1)>(vb), l1 = tr_read<v_rd_off(D0, 1, 0)>(vb), h1 = tr_read<v_rd_off(D0, 1, 1)>(vb);
    const s16x4 l2 = tr_read<v_rd_off(D0, 2, 0)>(vb), h2 = tr_read<v_rd_off(D0, 2, 1)>(vb), l3 = tr_read<v_rd_off(D0, 3, 0)>(vb), h3 = tr_read<v_rd_off(D0, 3, 1)>(vb);
    asm volatile("s_waitcnt lgkmcnt(0)" ::: "memory"); SBAR();
#define PK(L, H) (bf16x8){L[0], L[1], L[2], L[3], H[0], H[1], H[2], H[3]}
    od = __builtin_amdgcn_mfma_f32_32x32x16_bf16(pa0, PK(l0, h0), od, 0, 0, 0);
    od = __builtin_amdgcn_mfma_f32_32x32x16_bf16(pa1, PK(l1, h1), od, 0, 0, 0);
    od = __builtin_amdgcn_mfma_f32_32x32x16_bf16(pa2, PK(l2, h2), od, 0, 0, 0);
    od = __builtin_amdgcn_mfma_f32_32x32x16_bf16(pa3, PK(l3, h3), od, 0, 0, 0);
#undef PK
}
DI void pv_d0(f32x16* o, int vb, bf16x8 pa0, bf16x8 pa1, bf16x8 pa2, bf16x8 pa3) {
    pv_one<0>(o[0], vb, pa0, pa1, pa2, pa3); pv_one<1>(o[1], vb, pa0, pa1, pa2, pa3); pv_one<2>(o[2], vb, pa0, pa1, pa2, pa3); pv_one<3>(o[3], vb, pa0, pa1, pa2, pa3);
}

DI int v_rd_base2(int lane) { return ((lane & 3) << 3) | (((lane >> 2) & 3) << 6) | (((lane >> 4) & 1) << 5) | (((lane >> 5) & 1) << 11); }
constexpr int v_rd_off2(int d0, int ks, int half) { return d0 * 512 + ks * 4096 + half * 256; }
DI void finishSM5(f32x16& p0, f32x16& p1, float alpha, float& l_reg, bf16x8& pa0, bf16x8& pa1, bf16x8& pa2, bf16x8& pa3) {
#pragma unroll
    for (int r = 0; r < 16; ++r) p1[r] = __builtin_amdgcn_exp2f(p1[r]);
    float ps = 0;
#pragma unroll
    for (int r = 0; r < 16; ++r) ps += p0[r];
#pragma unroll
    for (int r = 0; r < 16; ++r) ps += p1[r];
    { auto rr = __builtin_amdgcn_permlane32_swap(__float_as_uint(ps), __float_as_uint(ps), false, false);
      ps = __uint_as_float(rr[0]) + __uint_as_float(rr[1]); }
    l_reg = l_reg * alpha + ps;
#define PK8(P, BASE, OUT) do { u32x4 w = {cvtpk(P[BASE + 0], P[BASE + 1]), cvtpk(P[BASE + 2], P[BASE + 3]), cvtpk(P[BASE + 4], P[BASE + 5]), cvtpk(P[BASE + 6], P[BASE + 7])}; OUT = *reinterpret_cast<bf16x8*>(&w); } while (0)
    PK8(p0, 0, pa0); PK8(p0, 8, pa1); PK8(p1, 0, pa2); PK8(p1, 8, pa3);
#undef PK8
}
template <int D0> DI void pv_one2(f32x16& od, int vb, bf16x8 pa0, bf16x8 pa1, bf16x8 pa2, bf16x8 pa3) {
    const s16x4 l0 = tr_read<v_rd_off2(D0, 0, 0)>(vb), h0 = tr_read<v_rd_off2(D0, 0, 1)>(vb), l1 = tr_read<v_rd_off2(D0, 1, 0)>(vb), h1 = tr_read<v_rd_off2(D0, 1, 1)>(vb);
    const s16x4 l2 = tr_read<v_rd_off2(D0, 2, 0)>(vb), h2 = tr_read<v_rd_off2(D0, 2, 1)>(vb), l3 = tr_read<v_rd_off2(D0, 3, 0)>(vb), h3 = tr_read<v_rd_off2(D0, 3, 1)>(vb);
    asm volatile("s_waitcnt lgkmcnt(0)" ::: "memory"); SBAR();
#define PK(L, H) (bf16x8){L[0], L[1], L[2], L[3], H[0], H[1], H[2], H[3]}
    od = __builtin_amdgcn_mfma_f32_32x32x16_bf16(pa0, PK(l0, h0), od, 0, 0, 0);
    od = __builtin_amdgcn_mfma_f32_32x32x16_bf16(pa1, PK(l1, h1), od, 0, 0, 0);
    od = __builtin_amdgcn_mfma_f32_32x32x16_bf16(pa2, PK(l2, h2), od, 0, 0, 0);
    od = __builtin_amdgcn_mfma_f32_32x32x16_bf16(pa3, PK(l3, h3), od, 0, 0, 0);
#undef PK
}
DI void pv_d0_2(f32x16* o, int vb, bf16x8 pa0, bf16x8 pa1, bf16x8 pa2, bf16x8 pa3) {
    pv_one2<0>(o[0], vb, pa0, pa1, pa2, pa3); pv_one2<1>(o[1], vb, pa0, pa1, pa2, pa3); pv_one2<2>(o[2], vb, pa0, pa1, pa2, pa3); pv_one2<3>(o[3], vb, pa0, pa1, pa2, pa3);
}
DI void partialSM6(f32x16& p0, f32x16& p1, float& m_reg, float& alpha, bool first) {
    float pmax = p0[0];
#pragma unroll
    for (int r = 1; r < 16; ++r) pmax = fmaxf(pmax, p0[r]);
#pragma unroll
    for (int r = 0; r < 16; ++r) pmax = fmaxf(pmax, p1[r]);
    alpha = 1.f; asm volatile("" : "+v"(pmax));
    if (__builtin_expect(first || !__all(pmax <= THRL), 0)) {
        { auto rr = __builtin_amdgcn_permlane32_swap(__float_as_uint(pmax), __float_as_uint(pmax), false, false);
          pmax = fmaxf(__uint_as_float(rr[0]), __uint_as_float(rr[1])); }
        const float delta = first ? pmax : (pmax <= THRL ? 0.f : pmax);
        if (!first) alpha = __builtin_amdgcn_exp2f(-delta);
        m_reg += delta;
#pragma unroll
        for (int r = 0; r < 16; ++r) { p0[r] -= delta; p1[r] -= delta; }
    }
#pragma unroll
    for (int r = 0; r < 16; ++r) p0[r] = __builtin_amdgcn_exp2f(p0[r]);
}
DI void finishSM6(f32x16& p0, f32x16& p1, float alpha, float& l_reg, bf16x8& pa0, bf16x8& pa1, bf16x8& pa2, bf16x8& pa3) {
#pragma unroll
    for (int r = 0; r < 16; ++r) p1[r] = __builtin_amdgcn_exp2f(p1[r]);
    float ps = l_reg * alpha;
#pragma unroll
    for (int r = 0; r < 16; ++r) ps += p0[r];
#pragma unroll
    for (int r = 0; r < 16; ++r) ps += p1[r];
    asm volatile("" : "+v"(ps)); l_reg = ps;
#define PK8(P, BASE, OUT) do { u32x4 w = {cvtpk(P[BASE + 0], P[BASE + 1]), cvtpk(P[BASE + 2], P[BASE + 3]), cvtpk(P[BASE + 4], P[BASE + 5]), cvtpk(P[BASE + 6], P[BASE + 7])}; OUT = *reinterpret_cast<bf16x8*>(&w); } while (0)
    PK8(p0, 0, pa0); PK8(p0, 8, pa1); PK8(p1, 0, pa2); PK8(p1, 8, pa3);
#undef PK8
}
constexpr float EBIG = 2978.0f;
DI void softmax7(f32x16& p0, f32x16& p1, float& m_reg, float& l_reg, float& alpha, bool first, bf16x8& pa0, bf16x8& pa1, bf16x8& pa2, bf16x8& pa3) {
#pragma unroll
    for (int r = 0; r < 16; ++r) p0[r] = __builtin_amdgcn_exp2f(p0[r]);
#pragma unroll
    for (int r = 0; r < 16; ++r) p1[r] = __builtin_amdgcn_exp2f(p1[r]);
    float ps = 0.f;
#pragma unroll
    for (int r = 0; r < 16; ++r) ps += p0[r];
#pragma unroll
    for (int r = 0; r < 16; ++r) ps += p1[r];
    alpha = 1.f; asm volatile("" : "+v"(ps));
    if (__builtin_expect(first || !__all(ps <= EBIG), 0)) {
        float emax = p0[0];
#pragma unroll
        for (int r = 1; r < 16; ++r) emax = fmaxf(emax, p0[r]);
#pragma unroll
        for (int r = 0; r < 16; ++r) emax = fmaxf(emax, p1[r]);
        { auto rr = __builtin_amdgcn_permlane32_swap(__float_as_uint(emax), __float_as_uint(emax), false, false);
          emax = fmaxf(__uint_as_float(rr[0]), __uint_as_float(rr[1])); }
        const float delta = (first || emax > EBIG) ? __builtin_amdgcn_logf(emax) : 0.f;
        const float f = __builtin_amdgcn_exp2f(-delta);
        if (!first) alpha = f;
        m_reg += delta; ps *= f;
#pragma unroll
        for (int r = 0; r < 16; ++r) { p0[r] *= f; p1[r] *= f; }
    }
    l_reg = l_reg * alpha + ps;
#define PK8(P, BASE, OUT) do { u32x4 w = {cvtpk(P[BASE + 0], P[BASE + 1]), cvtpk(P[BASE + 2], P[BASE + 3]), cvtpk(P[BASE + 4], P[BASE + 5]), cvtpk(P[BASE + 6], P[BASE + 7])}; OUT = *reinterpret_cast<bf16x8*>(&w); } while (0)
    PK8(p0, 0, pa0); PK8(p0, 8, pa1); PK8(p1, 0, pa2); PK8(p1, 8, pa3);
#undef PK8
}
DI void softmax8(f32x16& p0, f32x16& p1, float& m_reg, float& l_reg, float& alpha, bool& shifted, float frame_t, bf16x8& pa0, bf16x8& pa1, bf16x8& pa2, bf16x8& pa3) {
    if (__builtin_expect(shifted, 0)) {
#pragma unroll
        for (int r = 0; r < 16; ++r) { p0[r] -= m_reg; p1[r] -= m_reg; }
    }
#pragma unroll
    for (int r = 0; r < 16; ++r) p0[r] = __builtin_amdgcn_exp2f(p0[r]);
#pragma unroll
    for (int r = 0; r < 16; ++r) p1[r] = __builtin_amdgcn_exp2f(p1[r]);
    float ps = 0.f;
#pragma unroll
    for (int r = 0; r < 16; ++r) ps += p0[r];
#pragma unroll
    for (int r = 0; r < 16; ++r) ps += p1[r];
    alpha = frame_t; asm volatile("" : "+v"(ps));
    if (__builtin_expect(!__all(ps <= EBIG), 0)) {
        float emax = p0[0];
#pragma unroll
        for (int r = 1; r < 16; ++r) emax = fmaxf(emax, p0[r]);
#pragma unroll
        for (int r = 0; r < 16; ++r) emax = fmaxf(emax, p1[r]);
        { auto rr = __builtin_amdgcn_permlane32_swap(__float_as_uint(emax), __float_as_uint(emax), false, false);
          emax = fmaxf(__uint_as_float(rr[0]), __uint_as_float(rr[1])); }
        const float delta = emax > EBIG ? __builtin_amdgcn_logf(emax) : 0.f;
        const float f = __builtin_amdgcn_exp2f(-delta);
        alpha *= f; m_reg += delta; ps *= f; shifted = true;
#pragma unroll
        for (int r = 0; r < 16; ++r) { p0[r] *= f; p1[r] *= f; }
    }
    l_reg = l_reg * alpha + ps;
#define PK8(P, BASE, OUT) do { u32x4 w = {cvt_pk_bf16(P[BASE + 0], P[BASE + 1]), cvt_pk_bf16(P[BASE + 2], P[BASE + 3]), cvt_pk_bf16(P[BASE + 4], P[BASE + 5]), cvt_pk_bf16(P[BASE + 6], P[BASE + 7])}; OUT = *reinterpret_cast<bf16x8*>(&w); } while (0)
    PK8(p0, 0, pa0); PK8(p0, 8, pa1); PK8(p1, 0, pa2); PK8(p1, 8, pa3);
#undef PK8
}
#define TRK(KS, R) do { R##0 = tr_read<v_rd_off2(0, KS, 0)>(vb); R##1 = tr_read<v_rd_off2(0, KS, 1)>(vb); R##2 = tr_read<v_rd_off2(1, KS, 0)>(vb); R##3 = tr_read<v_rd_off2(1, KS, 1)>(vb); \
    R##4 = tr_read<v_rd_off2(2, KS, 0)>(vb); R##5 = tr_read<v_rd_off2(2, KS, 1)>(vb); R##6 = tr_read<v_rd_off2(3, KS, 0)>(vb); R##7 = tr_read<v_rd_off2(3, KS, 1)>(vb); } while (0)
#define PKV(L, H) (bf16x8){L[0], L[1], L[2], L[3], H[0], H[1], H[2], H[3]}
#define PVK(PA, R) do { o[0] = __builtin_amdgcn_mfma_f32_32x32x16_bf16(PA, PKV(R##0, R##1), o[0], 0, 0, 0); o[1] = __builtin_amdgcn_mfma_f32_32x32x16_bf16(PA, PKV(R##2, R##3), o[1], 0, 0, 0); \
    o[2] = __builtin_amdgcn_mfma_f32_32x32x16_bf16(PA, PKV(R##4, R##5), o[2], 0, 0, 0); o[3] = __builtin_amdgcn_mfma_f32_32x32x16_bf16(PA, PKV(R##6, R##7), o[3], 0, 0, 0); } while (0)
DI void mseg_pv(f32x16& p0, f32x16& p1, f32x16* o, const char* Ks, int vb, const bf16x8* qr, int r32, int hi, int map, bf16x8 pa0, bf16x8 pa1, bf16x8 pa2, bf16x8 pa3, const f32x16& cinit = f32x16{}) {
    s16x4 a0, a1, a2, a3, a4, a5, a6, a7, b0, b1, b2, b3, b4, b5, b6, b7;
    TRK(0, a);
    { bf16x8 kf[8];
#pragma unroll
      for (int d0 = 0; d0 < 4; ++d0) { const int cb = ((map * 4 + d0) * 16 + hi * 8) * 2; const int ka = (int)(uintptr_t)Ks + KSWZ(r32, cb);
          asm volatile("ds_read_b128 %0, %1" : "=&v"(kf[2 * d0]) : "v"(ka) : "memory");
          asm volatile("ds_read_b128 %0, %1 offset:8192" : "=&v"(kf[2 * d0 + 1]) : "v"(ka) : "memory"); }
      asm volatile("s_waitcnt lgkmcnt(0)" ::: "memory"); SBAR();
      p0 = cinit; p1 = cinit;
#pragma unroll
      for (int d0 = 0; d0 < 4; ++d0) { p0 = __builtin_amdgcn_mfma_f32_32x32x16_bf16(kf[2 * d0], qr[d0], p0, 0, 0, 0); p1 = __builtin_amdgcn_mfma_f32_32x32x16_bf16(kf[2 * d0 + 1], qr[d0], p1, 0, 0, 0); }
    }
    SBAR();
    TRK(1, b); SBAR();
    PVK(pa0, a); SBAR();
    TRK(2, a); asm volatile("s_waitcnt lgkmcnt(8)" ::: "memory"); SBAR();
    PVK(pa1, b); SBAR();
    TRK(3, b); asm volatile("s_waitcnt lgkmcnt(8)" ::: "memory"); SBAR();
    PVK(pa2, a); SBAR();
    asm volatile("s_waitcnt lgkmcnt(0)" ::: "memory"); SBAR();
    PVK(pa3, b);
}
#undef TRK
#undef PKV
#undef PVK
__device__ __forceinline__ void body(const bf16_t* __restrict__ Qs, const bf16_t* __restrict__ Kh, const bf16_t* __restrict__ Vh, bf16_t* __restrict__ Os,
                                     int seq, int qblk0, int head, float lam, const float* __restrict__ relb, const float* __restrict__ subg, char* lds) {
    int tid = threadIdx.x; asm volatile("" : "+v"(tid));
    const int wid = __builtin_amdgcn_readfirstlane(tid >> 6), lane = tid & 63, r32 = lane & 31, hi = lane >> 5, map = wid >> 2, wq = wid & 3;
    char* V_lds = lds; char* K_lds = lds + 2 * SHM_V;
    float* wsf = (float*)(lds + O_WS) + wid * 64; float* li_l = wsf; float* al_l = wsf + 32;
    float* lut = (float*)(lds + O_LUT);
    __syncthreads();
    if (tid < 257) lut[tid] = relb[rel_bucket(tid - 128) * 8 + head] * (1.0f / SCALE);
    const float cL = relb[15 * 8 + head] * (1.0f / SCALE), cR = relb[31 * 8 + head] * (1.0f / SCALE);
    float m_reg = -1e30f, l_reg = 0; f32x16 o[4] = {}; bf16x8 qr[4];
    const int qpos = qblk0 + wq * 32 + r32;
    const bf16_t* Qw = Qs + (size_t)qpos * LDQ + map * 64 + hi * 8;
#pragma unroll
    for (int d0 = 0; d0 < 4; ++d0) qr[d0] = *reinterpret_cast<const bf16x8*>(Qw + d0 * 16);
    const int sr = tid >> 4, sc = (tid & 15) * 8, vst0 = v_st(sr, sc), vst1 = v_st(32 + sr, sc);
    const int vb0 = (int)(uintptr_t)V_lds + v_rd_base(lane);
    struct { bf16x8 vs0, vs1, ks0, ks1; } sr_[2];
#define SLOAD(i, k0) do { sr_[i].vs0 = *(const bf16x8*)(&Vh[(size_t)((k0) + sr) * LDK + sc]); sr_[i].vs1 = *(const bf16x8*)(&Vh[(size_t)((k0) + 32 + sr) * LDK + sc]); \
    sr_[i].ks0 = *(const bf16x8*)(&Kh[(size_t)((k0) + sr) * LDK + sc]); sr_[i].ks1 = *(const bf16x8*)(&Kh[(size_t)((k0) + 32 + sr) * LDK + sc]); } while (0)
#define SWRITE(b, i) do { *(bf16x8*)(V_lds + (b) * SHM_V + vst0) = sr_[i].vs0;          \
    *(bf16x8*)(V_lds + (b) * SHM_V + vst1) = sr_[i].vs1; const int kc = sc * 2;               \
    *(bf16x8*)(K_lds + (b) * SHM_K + KSWZ(sr, kc)) = sr_[i].ks0;                       \
    *(bf16x8*)(K_lds + (b) * SHM_K + KSWZ(32 + sr, kc)) = sr_[i].ks1; } while (0)
#define SWAIT() asm volatile("s_waitcnt vmcnt(4)" ::: "memory")
#define RESC(a) do { if (__any((a) < 1.f)) { if (hi == 0) al_l[r32] = (a); asm volatile("s_waitcnt lgkmcnt(0)" ::: "memory"); \
    _Pragma("unroll") for (int d = 0; d < 4; ++d) _Pragma("unroll") for (int r = 0; r < 16; ++r) o[d][r] *= al_l[crow(r, hi)]; } } while (0)
#define QKT(P0, P1, buf, j) qkt(P0, P1, K_lds + (buf) * SHM_K, qr, r32, hi, map)
#define PSM(P0, P1, MN, AL, j) do { const int kb_ = (j) * KVBLK; float cadd_ = 0.f; \
    if (kb_ + 63 - qblk0 <= -91) cadd_ = cL; else if (kb_ - (qblk0 + 127) >= 91) cadd_ = cR; else add_bias_near(P0, P1, kb_ - qpos + 4 * hi, lut); \
    partialSM(P0, P1, m_reg, MN, AL, cadd_); } while (0)
    f32x16 pA0, pA1, pB0, pB1; float mnA, mnB, alA, alB; bf16x8 pa0, pa1, pa2, pa3; const int NT = seq / KVBLK;
    constexpr int SE = 0, SO = 1;
    SLOAD(SE, 0); asm volatile("s_waitcnt vmcnt(0)" ::: "memory"); SWRITE(0, SE); __syncthreads();
    QKT(pA0, pA1, 0, 0); PSM(pA0, pA1, mnA, alA, 0);
    SLOAD(SO, KVBLK); if (2 < NT) SLOAD(SE, 2 * KVBLK);
    SWAIT(); SWRITE(1, SO); __syncthreads();
    for (int j = 1; j + 1 < NT; j += 2) {
        SBAR(); QKT(pB0, pB1, 1, j);
        finishSM(pA0, pA1, alA, l_reg, pa0, pa1, pa2, pa3); SBAR();
        SLOAD(SO, (j + 2) * KVBLK); SBAR();
        pv_d0(o, vb0, pa0, pa1, pa2, pa3); PSM(pB0, pB1, mnB, alB, j);
        __syncthreads(); SWAIT(); SWRITE(0, SE);
        RESC(alB); __syncthreads();
        SBAR(); QKT(pA0, pA1, 0, j + 1);
        finishSM(pB0, pB1, alB, l_reg, pa0, pa1, pa2, pa3); SBAR();
        if (j + 3 < NT) SLOAD(SE, (j + 3) * KVBLK); SBAR();
        pv_d0(o, vb0 + (int)SHM_V, pa0, pa1, pa2, pa3); PSM(pA0, pA1, mnA, alA, j + 1);
        __syncthreads(); SWAIT(); SWRITE(1, SO);
        RESC(alA); __syncthreads();
    }
    SBAR(); QKT(pB0, pB1, 1, NT - 1);
    finishSM(pA0, pA1, alA, l_reg, pa0, pa1, pa2, pa3); SBAR();
    pv_d0(o, vb0, pa0, pa1, pa2, pa3); PSM(pB0, pB1, mnB, alB, NT - 1);
    __syncthreads(); RESC(alB);
    finishSM(pB0, pB1, alB, l_reg, pa0, pa1, pa2, pa3); SBAR();
    pv_d0(o, vb0 + (int)SHM_V, pa0, pa1, pa2, pa3);
    if (hi == 0) li_l[r32] = l_reg; asm volatile("s_waitcnt lgkmcnt(0)" ::: "memory");
    float rli[16];
#pragma unroll
    for (int r = 0; r < 16; ++r) rli[r] = __builtin_amdgcn_rcpf(li_l[crow(r, hi)]) * (map ? -lam : 1.0f);
    __syncthreads();
    float* X = (float*)lds;
    if (map == 1) {
#pragma unroll
        for (int r = 0; r < 16; ++r) { const int row = wq * 32 + crow(r, hi);
#pragma unroll
            for (int d0 = 0; d0 < 4; ++d0) X[row * 128 + d0 * 32 + r32] = o[d0][r] * rli[r]; }
    }
    __syncthreads();
    if (map == 0) {
#pragma unroll
        for (int r = 0; r < 16; ++r) { const int row = wq * 32 + crow(r, hi);
#pragma unroll
            for (int d0 = 0; d0 < 4; ++d0) X[row * 128 + d0 * 32 + r32] += o[d0][r] * rli[r]; }
    }
    __syncthreads();
    { const int row = tid >> 2, part = tid & 3; float v[32]; float s = 0.f;
#pragma unroll
      for (int k = 0; k < 8; ++k) { const f32x4 x = *(const f32x4*)(X + row * 128 + part * 32 + k * 4); v[4 * k] = x[0]; v[4 * k + 1] = x[1]; v[4 * k + 2] = x[2]; v[4 * k + 3] = x[3]; s += x[0] * x[0] + x[1] * x[1] + x[2] * x[2] + x[3] * x[3]; }
      s += __shfl_xor(s, 1); s += __shfl_xor(s, 2);
      const float rs = rsqrtf(s * (1.0f / 128.0f) + EPS) * (1.0f - LAMBDA_INIT1);
      bf16_t* op = Os + (size_t)(qblk0 + row) * 1024 + part * 32;
#pragma unroll
      for (int k = 0; k < 4; ++k) { const f32x4 g0 = *(const f32x4*)(subg + part * 32 + k * 8), g1 = *(const f32x4*)(subg + part * 32 + k * 8 + 4);
          pg8::st_bf16x8(op + k * 8, (f32x4){v[8 * k] * rs * g0[0], v[8 * k + 1] * rs * g0[1], v[8 * k + 2] * rs * g0[2], v[8 * k + 3] * rs * g0[3]},
                         (f32x4){v[8 * k + 4] * rs * g1[0], v[8 * k + 5] * rs * g1[1], v[8 * k + 6] * rs * g1[2], v[8 * k + 7] * rs * g1[3]}); } }
#undef SLOAD
#undef SWRITE
#undef SWAIT
#undef RESC
#undef QKT
#undef PSM
}
__device__ __forceinline__ void body2(const bf16_t* __restrict__ Qs, const bf16_t* __restrict__ Kh, const bf16_t* __restrict__ Vh, bf16_t* __restrict__ Os,
                                     int seq, int qblk0, int head, float lam, const float* __restrict__ relb, const float* __restrict__ subg, char* lds) {
    int tid = threadIdx.x; asm volatile("" : "+v"(tid));
    const int wid = __builtin_amdgcn_readfirstlane(tid >> 6), lane = tid & 63, r32 = lane & 31, hi = lane >> 5, map = wid >> 2, wq = wid & 3;
    char* V_lds = lds; char* K_lds = lds + 2 * SHM_V;
    float* wsf = (float*)(lds + O_WS) + wid * 64; float* li_l = wsf; float* al_l = wsf + 32;
    float* lut = (float*)(lds + O_LUT);
    __syncthreads();
    if (tid < 257) lut[tid] = relb[rel_bucket(tid - 128) * 8 + head] * (1.0f / SCALE);
    const float cL = relb[15 * 8 + head] * (1.0f / SCALE), cR = relb[31 * 8 + head] * (1.0f / SCALE);
    float m_reg = -1e30f, l_reg = 0; f32x16 o[4] = {}; bf16x8 qr[4];
    const int qpos = qblk0 + wq * 32 + r32;
    const bf16_t* Qw = Qs + (size_t)qpos * LDQ + map * 64 + hi * 8;
#pragma unroll
    for (int d0 = 0; d0 < 4; ++d0) qr[d0] = *reinterpret_cast<const bf16x8*>(Qw + d0 * 16);
    const int sr = tid >> 4, sc = (tid & 15) * 8, vst0 = v_st(sr, sc), vst1 = v_st(32 + sr, sc);
    const int vb0 = (int)(uintptr_t)V_lds + v_rd_base(lane);
    bf16x8 ks0, ks1, vs0, vs1;
    const unsigned toff = (unsigned)(sr * LDK + sc) * 2u;
#define KLOAD(k0) do { const char* kb_ = (const char*)Kh + (size_t)(k0) * (LDK * 2); ks0 = *(const bf16x8*)(kb_ + toff); ks1 = *(const bf16x8*)(kb_ + 32 * LDK * 2 + toff); } while (0)
#define VLOAD(k0) do { const char* vb_ = (const char*)Vh + (size_t)(k0) * (LDK * 2); vs0 = *(const bf16x8*)(vb_ + toff); vs1 = *(const bf16x8*)(vb_ + 32 * LDK * 2 + toff); } while (0)
#define KWRITE(b) do { const int kc = sc * 2; *(bf16x8*)(K_lds + (b) * SHM_K + KSWZ(sr, kc)) = ks0; *(bf16x8*)(K_lds + (b) * SHM_K + KSWZ(32 + sr, kc)) = ks1; } while (0)
#define VWRITE(b) do { *(bf16x8*)(V_lds + (b) * SHM_V + vst0) = vs0; *(bf16x8*)(V_lds + (b) * SHM_V + vst1) = vs1; } while (0)
#define RESC(a) do { if (__any((a) < 1.f)) { if (hi == 0) al_l[r32] = (a); asm volatile("s_waitcnt lgkmcnt(0)" ::: "memory"); \
    _Pragma("unroll") for (int d = 0; d < 4; ++d) _Pragma("unroll") for (int r = 0; r < 16; ++r) o[d][r] *= al_l[crow(r, hi)]; } } while (0)
#define PSM(P0, P1, MN, AL, j) do { const int kb_ = (j) * KVBLK; float cadd_ = 0.f; \
    if (kb_ + 63 - qblk0 <= -91) cadd_ = cL; else if (kb_ - (qblk0 + 127) >= 91) cadd_ = cR; else add_bias_near(P0, P1, kb_ - qpos + 4 * hi, lut); \
    partialSM(P0, P1, m_reg, MN, AL, cadd_); } while (0)
#define MSEG(j) do { qkt(p0, p1, K_lds + ((j) & 1) * SHM_K, qr, r32, hi, map); if ((j) > 0) pv_d0(o, vb0 + (((j) - 1) & 1) * (int)SHM_V, pa0, pa1, pa2, pa3); } while (0)
#ifdef X_NORESC
#define VSEG(j) do { PSM(p0, p1, mn, al, (j)); finishSM(p0, p1, al, l_reg, pa0, pa1, pa2, pa3); } while (0)
#else
#define VSEG(j) do { PSM(p0, p1, mn, al, (j)); RESC(al); finishSM(p0, p1, al, l_reg, pa0, pa1, pa2, pa3); } while (0)
#endif
    f32x16 p0, p1; float mn, al; bf16x8 pa0, pa1, pa2, pa3; const int NT = seq / KVBLK;
    KLOAD(0); KWRITE(0);
#define STAGE(j) do { if ((j) + 1 < NT) KWRITE(((j) + 1) & 1); VWRITE((j) & 1); if ((j) + 2 < NT) KLOAD(((j) + 2) * KVBLK); if ((j) + 1 < NT) VLOAD(((j) + 1) * KVBLK); SBAR(); } while (0)
    KLOAD(KVBLK); VLOAD(0);
    __syncthreads();
    if (map == 0) {
        qkt(p0, p1, K_lds, qr, r32, hi, 0);
        STAGE(0); VSEG(0); __syncthreads();
        for (int j = 1; j < NT; ++j) {
            mseg_pv(p0, p1, o, K_lds + (j & 1) * SHM_K, vb0 + ((j - 1) & 1) * (int)SHM_V, qr, r32, hi, 0, pa0, pa1, pa2, pa3);
            STAGE(j); VSEG(j);
            __syncthreads();
        }
        pv_d0(o, vb0 + ((NT - 1) & 1) * (int)SHM_V, pa0, pa1, pa2, pa3);
    } else {
        STAGE(0); qkt(p0, p1, K_lds, qr, r32, hi, 1); __syncthreads();
        for (int j = 1; j < NT; ++j) {
            VSEG(j - 1);
            STAGE(j);
            mseg_pv(p0, p1, o, K_lds + (j & 1) * SHM_K, vb0 + ((j - 1) & 1) * (int)SHM_V, qr, r32, hi, 1, pa0, pa1, pa2, pa3);
            __syncthreads();
        }
        VSEG(NT - 1);
        pv_d0(o, vb0 + ((NT - 1) & 1) * (int)SHM_V, pa0, pa1, pa2, pa3);
    }
#undef STAGE
    if (hi == 0) li_l[r32] = l_reg; asm volatile("s_waitcnt lgkmcnt(0)" ::: "memory");
    float rli[16];
#pragma unroll
    for (int r = 0; r < 16; ++r) rli[r] = __builtin_amdgcn_rcpf(li_l[crow(r, hi)]) * (map ? -lam : 1.0f);
    __syncthreads();
    float* X = (float*)lds;
    if (map == 1) {
#pragma unroll
        for (int r = 0; r < 16; ++r) { const int row = wq * 32 + crow(r, hi);
#pragma unroll
            for (int d0 = 0; d0 < 4; ++d0) X[row * 128 + d0 * 32 + r32] = o[d0][r] * rli[r]; }
    }
    __syncthreads();
    if (map == 0) {
#pragma unroll
        for (int r = 0; r < 16; ++r) { const int row = wq * 32 + crow(r, hi);
#pragma unroll
            for (int d0 = 0; d0 < 4; ++d0) X[row * 128 + d0 * 32 + r32] += o[d0][r] * rli[r]; }
    }
    __syncthreads();
    { const int row = tid >> 2, part = tid & 3; float v[32]; float s = 0.f;
#pragma unroll
      for (int k = 0; k < 8; ++k) { const f32x4 x = *(const f32x4*)(X + row * 128 + part * 32 + k * 4); v[4 * k] = x[0]; v[4 * k + 1] = x[1]; v[4 * k + 2] = x[2]; v[4 * k + 3] = x[3]; s += x[0] * x[0] + x[1] * x[1] + x[2] * x[2] + x[3] * x[3]; }
      s += __shfl_xor(s, 1); s += __shfl_xor(s, 2);
      const float rs = rsqrtf(s * (1.0f / 128.0f) + EPS) * (1.0f - LAMBDA_INIT1);
      bf16_t* op = Os + (size_t)(qblk0 + row) * 1024 + part * 32;
#pragma unroll
      for (int k = 0; k < 4; ++k) { const f32x4 g0 = *(const f32x4*)(subg + part * 32 + k * 8), g1 = *(const f32x4*)(subg + part * 32 + k * 8 + 4);
          pg8::st_bf16x8(op + k * 8, (f32x4){v[8 * k] * rs * g0[0], v[8 * k + 1] * rs * g0[1], v[8 * k + 2] * rs * g0[2], v[8 * k + 3] * rs * g0[3]},
                         (f32x4){v[8 * k + 4] * rs * g1[0], v[8 * k + 5] * rs * g1[1], v[8 * k + 6] * rs * g1[2], v[8 * k + 7] * rs * g1[3]}); } }
#undef KLOAD
#undef VLOAD
#undef KWRITE
#undef VWRITE
#undef RESC
#undef PSM
#undef MSEG
#undef VSEG
}

constexpr int O_WS4 = 6 * 16384;
constexpr int O_LUT4 = O_WS4 + 8 * 64 * 4;
__device__ __forceinline__ void body4(const bf16_t* __restrict__ Qs, const bf16_t* __restrict__ Kh, const bf16_t* __restrict__ Vh, bf16_t* __restrict__ Os,
                                      int seq, int qblk0, int head, float lam, const float* __restrict__ relb, const float* __restrict__ subg, char* lds, LAS unsigned char* ldsl, int wv) {
    int tid = tid_of(wv); asm volatile("" : "+v"(tid));
    const int wid = wv, lane = tid & 63, r32 = lane & 31, hi = lane >> 5, map = wid >> 2, wq = wid & 3;
    char* V_lds = lds; char* K_lds = lds + 3 * SHM_V;
    LAS float* wsf = (LAS float*)(ldsl + O_WS4) + wid * 64; LAS float* li_l = wsf; LAS float* al_l = wsf + 32;
    LAS float* lutl = (LAS float*)(ldsl + O_LUT4); const float* lut = (const float*)(lds + O_LUT4);
    __syncthreads();
    if (tid < 257) lutl[tid] = relb[rel_bucket(tid - 128) * 8 + head] * 1.4426950408889634f;
    const float cL = relb[15 * 8 + head] * 1.4426950408889634f, cR = relb[31 * 8 + head] * 1.4426950408889634f;
    float m_reg = 0.f, l_reg = 0; f32x16 o[4] = {}; bf16x8 qr[4];
    const int qpos = qblk0 + wq * 32 + r32;
    const bf16_t* Qw = Qs + (size_t)qpos * LDQ + map * 64 + hi * 8;
#pragma unroll
    for (int d0 = 0; d0 < 4; ++d0) qr[d0] = *reinterpret_cast<const bf16x8*>(Qw + d0 * 16);
    const int vb0 = (int)(uintptr_t)V_lds + v_rd_base2(lane);
    unsigned gk0, gv0;
    { const int ch0 = wid;
      { const int row = ch0 * 4 + (lane >> 4), b = (lane & 15) * 16; gk0 = (unsigned)(row * 256 + (b ^ ((row & 7) << 4))); }
      { const int st = ch0 * 2 + (lane >> 5), kk = (st >> 2) * 8 + ((lane & 31) >> 2), k = (kk & ~0xC) | ((kk & 4) << 1) | ((kk & 8) >> 1), cc = (st & 3) * 32 + (lane & 3) * 8; gv0 = (unsigned)(k * 256 + cc * 2); }
    }
    LAS unsigned char* Vl = ldsl; LAS unsigned char* Kl = ldsl + 3 * SHM_V;
    const int NT = seq / KVBLK;
#define DMA_K(t, slot) do { const int t_ = (t) < NT ? (t) : NT - 1; const char* g_ = (const char*)Kh + (size_t)t_ * (KVBLK * 256); \
    __builtin_amdgcn_global_load_lds((const unsigned*)(g_ + gk0), (LAS unsigned*)(Kl + (slot) * 16384 + wid * 1024), 16, 0, 0); \
    __builtin_amdgcn_global_load_lds((const unsigned*)(g_ + 8192 + gk0), (LAS unsigned*)(Kl + (slot) * 16384 + 8192 + wid * 1024), 16, 0, 0); } while (0)
#define DMA_V(t, slot) do { const int t_ = (t) < NT ? (t) : NT - 1; const char* g_ = (const char*)Vh + (size_t)t_ * (KVBLK * 256); \
    __builtin_amdgcn_global_load_lds((const unsigned*)(g_ + gv0), (LAS unsigned*)(Vl + (slot) * 16384 + wid * 1024), 16, 0, 0); \
    __builtin_amdgcn_global_load_lds((const unsigned*)(g_ + 8192 + gv0), (LAS unsigned*)(Vl + (slot) * 16384 + 8192 + wid * 1024), 16, 0, 0); } while (0)
#define TBAR(n) do { asm volatile("s_waitcnt vmcnt(" #n ") lgkmcnt(0)" ::: "memory"); __builtin_amdgcn_s_barrier(); asm volatile("" ::: "memory"); } while (0)
#define RESC(a) do { if (__any((a) != 1.f)) { if (hi == 0) al_l[r32] = (a); asm volatile("s_waitcnt lgkmcnt(0)" ::: "memory"); \
    _Pragma("unroll") for (int d = 0; d < 4; ++d) _Pragma("unroll") for (int r = 0; r < 16; ++r) o[d][r] *= al_l[crow(r, hi)]; } } while (0)
#define TCLS(j) (((j) * KVBLK + 63 - qblk0 <= -91) ? 0 : (((j) * KVBLK - (qblk0 + 127) >= 91) ? 2 : 1))
#define TCV(c) ((c) == 0 ? cL : ((c) == 2 ? cR : 0.f))
#define VSEG(j) do { if (TCLS(j) == 1) add_bias_near(p0, p1, (j) * KVBLK - qpos + 4 * hi, lut); \
    float ft_ = 1.f; if ((j) > 0 && TCLS(j) != TCLS((j) - 1)) ft_ = __builtin_amdgcn_exp2f(TCV(TCLS((j) - 1)) - TCV(TCLS(j))); \
    softmax8(p0, p1, m_reg, l_reg, al, shifted, ft_, pa0, pa1, pa2, pa3); RESC(al); } while (0)
    f32x16 p0, p1; float al; bf16x8 pa0, pa1, pa2, pa3;
    bool shifted = false; const f32x16 cinit = f32x16{};
    DMA_K(0, 0); DMA_V(0, 0); DMA_K(1, 1);
    TBAR(0);
    int s0 = 0, s1 = 1, s2 = 2;
    if (map == 0) {
        DMA_K(2, s2); DMA_V(1, s1);
        qkt(p0, p1, K_lds + s0 * SHM_K, qr, r32, hi, 0, cinit);
        VSEG(0); TBAR(4);
        for (int j = 1; j < NT; ++j) {
            { const int t_ = s0; s0 = s1; s1 = s2; s2 = t_; }
            DMA_K(j + 2, s2); DMA_V(j + 1, s1);
            mseg_pv(p0, p1, o, K_lds + s0 * SHM_K, vb0 + s2 * (int)SHM_V, qr, r32, hi, 0, pa0, pa1, pa2, pa3, cinit);
            VSEG(j);
            TBAR(4);
        }
        pv_d0_2(o, vb0 + s0 * (int)SHM_V, pa0, pa1, pa2, pa3);
    } else {
        DMA_K(2, s2); DMA_V(1, s1);
        qkt(p0, p1, K_lds + s0 * SHM_K, qr, r32, hi, 1, cinit); TBAR(4);
        for (int j = 1; j < NT; ++j) {
            { const int t_ = s0; s0 = s1; s1 = s2; s2 = t_; }
            DMA_K(j + 2, s2); DMA_V(j + 1, s1);
            VSEG(j - 1);
            mseg_pv(p0, p1, o, K_lds + s0 * SHM_K, vb0 + s2 * (int)SHM_V, qr, r32, hi, 1, pa0, pa1, pa2, pa3, cinit);
            TBAR(4);
        }
        VSEG(NT - 1);
        pv_d0_2(o, vb0 + s0 * (int)SHM_V, pa0, pa1, pa2, pa3);
    }
    asm volatile("s_waitcnt vmcnt(0)" ::: "memory");
    li_l[lane] = l_reg; asm volatile("s_waitcnt lgkmcnt(0)" ::: "memory");
    { const float lr_ = li_l[r32] + li_l[32 + r32]; asm volatile("s_waitcnt lgkmcnt(0)" ::: "memory"); if (hi == 0) li_l[r32] = lr_; asm volatile("s_waitcnt lgkmcnt(0)" ::: "memory"); }
    float rli[16];
#pragma unroll
    for (int r = 0; r < 16; ++r) rli[r] = __builtin_amdgcn_rcpf(li_l[crow(r, hi)]) * (map ? -lam : 1.0f);
    __syncthreads();
    float* X = (float*)lds;
    if (map == 1) {
#pragma unroll
        for (int r = 0; r < 16; ++r) { const int row = wq * 32 + crow(r, hi);
#pragma unroll
            for (int d0 = 0; d0 < 4; ++d0) X[row * 128 + d0 * 32 + r32] = o[d0][r] * rli[r]; }
    }
    __syncthreads();
    if (map == 0) {
#pragma unroll
        for (int r = 0; r < 16; ++r) { const int row = wq * 32 + crow(r, hi);
#pragma unroll
            for (int d0 = 0; d0 < 4; ++d0) X[row * 128 + d0 * 32 + r32] += o[d0][r] * rli[r]; }
    }
    __syncthreads();
    { const int row = tid >> 2, part = tid & 3; float v[32]; float s2_ = 0.f;
#pragma unroll
      for (int k = 0; k < 8; ++k) { const f32x4 x = *(const f32x4*)(X + row * 128 + part * 32 + k * 4); v[4 * k] = x[0]; v[4 * k + 1] = x[1]; v[4 * k + 2] = x[2]; v[4 * k + 3] = x[3]; s2_ += x[0] * x[0] + x[1] * x[1] + x[2] * x[2] + x[3] * x[3]; }
      s2_ += __shfl_xor(s2_, 1); s2_ += __shfl_xor(s2_, 2);
      const float rs = rsqrtf(s2_ * (1.0f / 128.0f) + EPS) * (1.0f - LAMBDA_INIT1);
      bf16_t* op = Os + (size_t)(qblk0 + row) * 1024 + part * 32;
#pragma unroll
      for (int k = 0; k < 4; ++k) { const f32x4 g0 = *(const f32x4*)(subg + part * 32 + k * 8), g1 = *(const f32x4*)(subg + part * 32 + k * 8 + 4);
          pg8::st_bf16x8(op + k * 8, (f32x4){v[8 * k] * rs * g0[0], v[8 * k + 1] * rs * g0[1], v[8 * k + 2] * rs * g0[2], v[8 * k + 3] * rs * g0[3]},
                         (f32x4){v[8 * k + 4] * rs * g1[0], v[8 * k + 5] * rs * g1[1], v[8 * k + 6] * rs * g1[2], v[8 * k + 7] * rs * g1[3]}); } }
#undef DMA_K
#undef DMA_V
#undef TBAR
#undef RESC
#undef TCLS
#undef TCV
#undef VSEG
}
}

DI void grid_barrier(unsigned* ctr, unsigned& epoch, unsigned G, int wv) {
    asm volatile("s_waitcnt vmcnt(0)" ::: "memory");
    __syncthreads();
    if (wv == 0 && lane_id() == 0) {
        __builtin_amdgcn_fence(__ATOMIC_RELEASE, "agent");
        asm volatile("s_waitcnt vmcnt(0)" ::: "memory");
        __hip_atomic_fetch_add(ctr, 1u, __ATOMIC_RELAXED, __HIP_MEMORY_SCOPE_AGENT);
        const unsigned target = (epoch + 1u) * G;
        while (__hip_atomic_load(ctr, __ATOMIC_RELAXED, __HIP_MEMORY_SCOPE_AGENT) < target) __builtin_amdgcn_s_sleep(1);
        __builtin_amdgcn_fence(__ATOMIC_ACQUIRE, "agent");
        asm volatile("s_waitcnt vmcnt(0)" ::: "memory");
    }
    ++epoch;
    __syncthreads();
}

__global__ void __launch_bounds__(NTHREADS, 2) fwd_kernel(Params p) {
    extern __shared__ __attribute__((aligned(16))) unsigned char lds_raw[];
    LAS unsigned char* lds = (LAS unsigned char*)lds_raw;
    cg::grid_group grid = cg::this_grid();
    const int wv = __builtin_amdgcn_readfirstlane(threadIdx.x >> 6);
    const int G = gridDim.x, c = blockIdx.x;
#define tid tid_of(wv)
    unsigned char* ws = p.ws;
#ifdef PH_LO
    const int lo = PH_LO, hi = PH_HI;
#else
    const int lo = p.ph_lo, hi = p.ph_hi;
#endif
#define IN(k) (lo <= (k) && (k) < hi)
#define SEAM(k) do { if (IN(k) && IN((k) + 1)) { if ((k) == 0) grid.sync(); else grid_barrier(bar_ctr, bar_epoch, (unsigned)G, wv); } } while (0)
    unsigned* bar_ctr = (unsigned*)(ws + O_MISC + 16384); unsigned bar_epoch = 0;
    float* rowss = (float*)(ws + O_ROWSS);
    float* memss = (float*)(ws + O_MISC);
    float* lamp = (float*)(ws + O_MISC + 8192);
    const float* x_prompt = p.in[0]; const float* x_sample = p.in[1];
    bf16_t* R0 = (bf16_t*)(ws + O_R0); bf16_t* R1 = (bf16_t*)(ws + O_R1); bf16_t* R2 = (bf16_t*)(ws + O_R2);

    if (IN(0)) {
        LAS float* tl = (LAS float*)lds;
        for (int jb = 0; jb < 15; ++jb) {
            CvtJob J; J.sn0 = 0; J.sn1 = 0; J.sscale = 1.f; J.g = nullptr; J.K = 1024; J.ldd = 1024;
            const int l = (jb >= 7) ? (jb - 7) / 4 : 0, w = (jb >= 7) ? (jb - 7) % 4 : 0;
            switch (jb) {
            case 0: J.src = p.in[9]; J.lds_src = 3072; J.col0 = 0; J.N = 1024; J.nvalid = 1024; J.g = p.in[4]; J.dst = (bf16_t*)(ws + O_WA); J.sn0 = 512; J.sn1 = 1024; J.sscale = 0.08838834764831845f; break;
            case 1: J.src = p.in[10]; J.lds_src = 16; J.col0 = 0; J.N = 256; J.nvalid = 16; J.g = p.in[4]; J.dst = (bf16_t*)(ws + O_WA) + 1024 * 1024; break;
            case 2: J.src = p.in[9]; J.lds_src = 3072; J.col0 = 512; J.N = 1536; J.nvalid = 1536; J.g = p.in[4]; J.dst = (bf16_t*)(ws + O_WB); J.sn0 = 0; J.sn1 = 512; J.sscale = 0.08838834764831845f; break;
            case 3: J.src = p.in[9]; J.lds_src = 3072; J.col0 = 2048; J.N = 1024; J.nvalid = 1024; J.g = p.in[4]; J.dst = (bf16_t*)(ws + O_WO); break;
            case 4: J.src = p.in[13]; J.lds_src = 1024; J.col0 = 0; J.N = 1024; J.nvalid = 1024; J.dst = (bf16_t*)(ws + O_WAOUT); break;
            case 5: J.src = p.in[14]; J.lds_src = 3072; J.col0 = 0; J.N = 3072; J.nvalid = 3072; J.g = p.in[4] + 1024; J.dst = (bf16_t*)(ws + O_WQKV); J.sn0 = 0; J.sn1 = 1024; J.sscale = 0.18033688011112042f; break;
            case 6: J.src = p.in[17]; J.lds_src = 1024; J.col0 = 0; J.N = 1024; J.nvalid = 1024; J.dst = (bf16_t*)(ws + O_WBOUT); break;
            default:
                if (w == 0) { J.src = p.in[20] + (size_t)l * 1024 * 2048; J.lds_src = 2048; J.col0 = 0; J.N = 2048; J.nvalid = 2048; J.g = p.in[6] + l * 1024; J.dst = (bf16_t*)(ws + O_LAYER + l * L_SIZE + L_WKV); }
                else if (w == 1) { J.src = p.in[21] + (size_t)l * 1024 * 1024; J.lds_src = 1024; J.col0 = 0; J.N = 1024; J.nvalid = 1024; J.dst = (bf16_t*)(ws + O_LAYER + l * L_SIZE + L_WCOUT); }
                else if (w == 2) { J.src = p.in[22] + (size_t)l * 1024 * 4096; J.lds_src = 4096; J.col0 = 0; J.N = 4096; J.nvalid = 4096; J.g = p.in[7] + l * 1024; J.dst = (bf16_t*)(ws + O_LAYER + l * L_SIZE + L_W1); }
                else { J.src = p.in[23] + (size_t)l * 4096 * 1024; J.lds_src = 1024; J.col0 = 0; J.K = 4096; J.N = 1024; J.nvalid = 1024; J.ldd = 4096; J.dst = (bf16_t*)(ws + O_LAYER + l * L_SIZE + L_W2); }
                break;
            }
            const int nt = cvt_tiles(J);
            for (int t = c; t < nt; t += G) cvt_tile(J, t, tl, wv);
        }
        for (int l = 0; l < 2; ++l) { const float* src = p.in[19] + (size_t)l * 1024 * 1024; const float* g = p.in[5] + l * 1024; bf16_t* dst = (bf16_t*)(ws + O_LAYER + l * L_SIZE + L_WQG);
            for (int i = c * NTHREADS + tid; i < 1024 * 1024 / 8; i += G * NTHREADS) { const int row = i >> 7; const float s = g[row] * 0.0625f;
                const f32x4 a = *(const f32x4*)(src + (size_t)i * 8), b = *(const f32x4*)(src + (size_t)i * 8 + 4); pg8::st_bf16x8(dst + (size_t)i * 8, a * s, b * s); } }
        const int gw = c * 8 + (tid >> 6), nw = G * 8;
        rows_to_bf16(x_prompt, x_sample, T, TP, R0, rowss, gw, nw, true);
        rows_to_bf16(p.in[2], p.in[3], 1536, 512, (bf16_t*)(ws + O_MEMB), memss, gw, nw, false);
        if (c == 0 && tid < 64) { const float* lv = p.in[15]; float a = lv[tid] * lv[64 + tid], b = lv[128 + tid] * lv[192 + tid];
#pragma unroll
            for (int o = 32; o >= 1; o >>= 1) { a += __shfl_xor(a, o); b += __shfl_xor(b, o); }
            if (tid == 0) lamp[0] = __expf(a) - __expf(b) + LAMBDA_INIT1; }
        __syncthreads();
    }
    SEAM(0);
    if (IN(1)) {
        { pg8::Sched S{256, 5, G, c, 0, (const char*)R0, (const char*)(ws + O_WA), 256 * 1024 * 2, 256 * 1024 * 2, 0};
          pg8::EpiQKG E{R1, R1 + (size_t)T * 512, (float*)(ws + O_GATES), p.in[11], rowss};
          pg8::gemm_phase(lds, 1024, 1024, 1024, S, E, wv); }
        { pg8::Sched S{6, 256, G, c, 0, (const char*)(ws + O_WB), (const char*)R0, 256 * 1024 * 2, 256 * 1024 * 2, 0};
          pg8::EpiColScale E{(bf16_t*)p.out, T, rowss};
          pg8::gemm_phase(lds, 1024, 1024, 1024, S, E, wv); }
        { pg8::Sched S{6, 8, G, c, 0, (const char*)(ws + O_MEMB), (const char*)(ws + O_LAYER + L_WKV), 256 * 1024 * 2, 256 * 1024 * 2, 0};
          pg8::EpiPlain E{(bf16_t*)(ws + O_KVM), 2048, memss};
          pg8::gemm_phase(lds, 1024, 1024, 1024, S, E, wv); }
    }
    SEAM(1);
    if (IN(2)) {
        for (int rep_ = 0; rep_ < REP_SCAN; ++rep_)
        if (G == 256) { if (c < 192) { const int q_ = c >> 3; scan::run(p, lds, (((q_ >> 2) * 8 + (c & 7)) << 2) + (q_ & 3), wv); } }
        else for (int item = c; item < 192; item += G) scan::run(p, lds, item, wv);
        { pg8::SchedM S{G, c, (const char*)(ws + O_KVM), (const char*)(ws + O_LAYER + L_WQG)}; pg8::EpiPlain E{(bf16_t*)(ws + O_MB), 1024, nullptr}; pg8::gemm_phase(lds, 256, 2048, 1024, S, E, wv); }
        { pg8::SchedN S{G, c, (const char*)(ws + O_KVM), (const char*)(ws + O_LAYER + L_WCOUT)}; pg8::EpiPlain E{(bf16_t*)(ws + O_NB), 1024, nullptr}; pg8::gemm_phase(lds, 256, 1024, 2048, S, E, wv); }
    }
    SEAM(2);
    if (IN(3)) rows_to_bf16(x_prompt, x_sample, T, TP, R1, nullptr, c * 8 + (tid >> 6), G * 8, false);
    SEAM(3);
    if (IN(4)) { pg8::Sched S{256, 4, G, c, 0, (const char*)R1, (const char*)(ws + O_WO), 256 * 1024 * 2, 256 * 1024 * 2, 0};
        pg8::EpiOGate E{R2, R0, p.in[12], rowss}; pg8::gemm_phase(lds, 1024, 1024, 1024, S, E, wv); }
    SEAM(4);
    if (IN(5)) { pg8::Sched S{256, 4, G, c, 0, (const char*)R2, (const char*)(ws + O_WAOUT), 256 * 1024 * 2, 256 * 1024 * 2, 0};
        pg8::EpiRes<0> E{x_prompt, x_sample, p.out, R0, rowss + 1 * 4 * T}; pg8::gemm_phase(lds, 1024, 1024, 1024, S, E, wv); }
    SEAM(5);
#define CROSS_MLP(PH, XB, XA, HID, LOFF, SS0, SS1, SS2, W2MODE)                                                                                              \
    if (IN(PH)) { pg8::Sched S{256, 4, G, c, 0, (const char*)(XB), (const char*)(ws + O_MB), 256 * 1024 * 2, 256 * 1024 * 2, 1024 * 1024 * 2};    \
        pg8::EpiSoftmax E{(XA), rowss + (SS0) * 4 * T}; pg8::gemm_phase(lds, 1024, 1024, 1024, S, E, wv); }                                                  \
    SEAM(PH);                                                                                                                                        \
    if (IN(PH + 1)) { pg8::Sched S{256, 4, G, c, 0, (const char*)(XA), (const char*)(ws + O_NB), 256 * 1024 * 2, 256 * 1024 * 2, 1024 * 1024 * 2}; \
        pg8::EpiRes<1> E{nullptr, nullptr, p.out, (XB), rowss + (SS1) * 4 * T}; pg8::gemm_phase(lds, 1024, 1024, 1024, S, E, wv); }            \
    SEAM(PH + 1);                                                                                                                                    \
    for (int half = 0; half < 2; ++half) {                                                                                                           \
        if (IN(PH + 2 + 2 * half)) { pg8::Sched S{128, 16, G, c, half * 128, (const char*)(XB), (const char*)(ws + O_LAYER + (LOFF) + L_W1), 256 * 1024 * 2, 256 * 1024 * 2, 0}; \
            pg8::EpiSqRelu E{(HID), 4096, rowss + (SS1) * 4 * T, half * TP}; pg8::gemm_phase(lds, 1024, 1024, 1024, S, E, wv); }                             \
        SEAM(PH + 2 + 2 * half);                                                                                                                     \
        if (IN(PH + 3 + 2 * half)) { pg8::Sched S{128, 4, G, c, half * 128, (const char*)((HID) - (size_t)half * TP * 4096), (const char*)(ws + O_LAYER + (LOFF) + L_W2), 256 * 4096 * 2, 256 * 4096 * 2, 0}; \
            pg8::EpiRes<W2MODE> E{nullptr, nullptr, p.out, (XB), rowss + (SS2) * 4 * T}; pg8::gemm_phase(lds, 4096, 4096, 4096, S, E, wv); }         \
        SEAM(PH + 3 + 2 * half);                                                                                                                     \
    }
    CROSS_MLP(6, R0, R1, R1, 0, 1, 2, 3, 1)
#define ATTN_GRP(grp) { \
        constexpr int PH = 12 + 2 * grp; \
        if (IN(PH)) { \
            { pg8::Sched S{128, 12, G, c, grp * 128, (const char*)R0, (const char*)(ws + O_WQKV), 256 * 1024 * 2, 256 * 1024 * 2, 0}; \
              pg8::EpiQKVh E{R1, rowss + 3 * 4 * T, grp * TP}; pg8::gemm_phase(lds, 1024, 1024, 1024, S, E, wv); } \
            if (grp == 0) { pg8::Sched S{6, 8, G, c, 0, (const char*)(ws + O_MEMB), (const char*)(ws + O_LAYER + L_SIZE + L_WKV), 256 * 1024 * 2, 256 * 1024 * 2, 0}; \
              pg8::EpiPlain E{(bf16_t*)(ws + O_KVM), 2048, memss}; pg8::gemm_phase(lds, 1024, 1024, 1024, S, E, wv); } \
        } \
        SEAM(PH); \
        if (IN(PH + 1)) { \
            const float lam = lamp[0]; \
            const int S = grp ? 8192 : 16384, nqb = S / 128; \
            for (int rep_ = 0; rep_ < REP_ATTN; ++rep_) \
            for (int item = ((c & 7) * (G >> 3) + (c >> 3)); item < 2048; item += G) { \
                const int qb = item % nqb, sh = item / nqb, head = sh & 7, sq = sh >> 3; \
                const bf16_t* base = R1 + ((size_t)head * TP + (size_t)sq * S) * 128; \
                dattn::body4(base, base + (size_t)8 * TP * 128, base + (size_t)16 * TP * 128, \
                            (bf16_t*)p.out + ((size_t)grp * TP + (size_t)sq * S) * 1024 + head * 128, S, qb * 128, head, lam, p.in[18], p.in[16], (char*)lds_raw, lds, wv); \
            } \
            __syncthreads(); \
            if (grp == 0) { \
                { pg8::SchedM S2{G, c, (const char*)(ws + O_KVM), (const char*)(ws + O_LAYER + L_SIZE + L_WQG)}; pg8::EpiPlain E{(bf16_t*)(ws + O_MB), 1024, nullptr}; pg8::gemm_phase(lds, 256, 2048, 1024, S2, E, wv); } \
                { pg8::SchedN S2{G, c, (const char*)(ws + O_KVM), (const char*)(ws + O_LAYER + L_SIZE + L_WCOUT)}; pg8::EpiPlain E{(bf16_t*)(ws + O_NB), 1024, nullptr}; pg8::gemm_phase(lds, 256, 1024, 2048, S2, E, wv); } \
            } \
        } \
        SEAM(PH + 1); \
    }
    ATTN_GRP(0)
    ATTN_GRP(1)
#undef ATTN_GRP
    if (IN(16)) { pg8::Sched S{256, 4, G, c, 0, (const char*)p.out, (const char*)(ws + O_WBOUT), 256 * 1024 * 2, 256 * 1024 * 2, 0};
        pg8::EpiRes<1> E{nullptr, nullptr, p.out, R0, rowss + 4 * 4 * T}; pg8::gemm_phase(lds, 1024, 1024, 1024, S, E, wv); }
    SEAM(16);
    CROSS_MLP(17, R0, R1, R1, L_SIZE, 4, 5, 6, 1)
    if (IN(23)) {
        const float* gf = p.in[8]; const float* ss = rowss + 6 * 4 * T; const int lane = tid & 63;
        for (int row = c * 8 + (tid >> 6); row < T; row += G * 8) { const float sc = rstd4(ss, row);
#pragma unroll
            for (int i = 0; i < 2; ++i) { const int col = i * 512 + lane * 8; const u32x4 w = *(const u32x4*)(R0 + (size_t)row * 1024 + col);
                const f32x4 g0 = *(const f32x4*)(gf + col), g1 = *(const f32x4*)(gf + col + 4); float* op = p.out + (size_t)row * 1024 + col;
                *(f32x4*)op = (f32x4){bflo(w.x) * g0[0], bfhi(w.x) * g0[1], bflo(w.y) * g0[2], bfhi(w.y) * g0[3]} * sc;
                *(f32x4*)(op + 4) = (f32x4){bflo(w.z) * g1[0], bfhi(w.z) * g1[1], bflo(w.w) * g1[2], bfhi(w.w) * g1[3]} * sc; } }
    }
#undef IN
#undef SEAM
#undef tid
}

extern "C" void kernel_launch(void* const* d_in, const int* in_sizes, int n_in, void* d_out, int out_size, void* d_ws, size_t ws_size, hipStream_t stream) {
    static int grid = 0;
    if (grid == 0) {
        if (n_in != 24 || out_size != T * DM || ws_size < WS_END) { fprintf(stderr, "kernel_launch: unexpected shapes: n_in %d out %d ws %zu (need %zu)\n", n_in, out_size, ws_size, (size_t)WS_END); grid = -1; return; }
        int dev = 0, cus = 0, per_cu = 0;
        hipGetDevice(&dev); hipDeviceGetAttribute(&cus, hipDeviceAttributeMultiprocessorCount, dev);
        if (hipFuncSetAttribute((const void*)fwd_kernel, hipFuncAttributeMaxDynamicSharedMemorySize, LDS_BYTES) != hipSuccess) { fprintf(stderr, "kernel_launch: hipFuncSetAttribute failed\n"); grid = -1; return; }
        if (hipOccupancyMaxActiveBlocksPerMultiprocessor(&per_cu, (const void*)fwd_kernel, NTHREADS, LDS_BYTES) != hipSuccess || per_cu < 1) { fprintf(stderr, "kernel_launch: occupancy query says %d\n", per_cu); per_cu = 1; }
        (void)hipGetLastError();
        grid = cus;
    }
    if (grid < 0) return;
    if (hipMemsetAsync((char*)d_ws + O_MISC + 16384, 0, 256, stream) != hipSuccess) { fprintf(stderr, "kernel_launch: memset of the barrier word failed\n"); return; }
    Params p{};
    for (int i = 0; i < 24; ++i) p.in[i] = (const float*)d_in[i];
    p.out = (float*)d_out; p.ws = (unsigned char*)d_ws; p.ph_lo = 0; p.ph_hi = 24;
    void* args[] = {&p};
    hipError_t e = hipLaunchCooperativeKernel((const void*)fwd_kernel, dim3(grid), dim3(NTHREADS), args, LDS_BYTES, stream);
    if (e != hipSuccess) fprintf(stderr, "kernel_launch: cooperative launch failed: %s (grid %d)\n", hipGetErrorString(e), grid);
}
```

```cpp
#include <hip/hip_runtime.h>
#include <hip/hip_cooperative_groups.h>
#include <cstdio>
#include <cstdint>
namespace cg = cooperative_groups;

typedef unsigned short bf16_t;
typedef short bf16x8 __attribute__((ext_vector_type(8)));
typedef short s16x4 __attribute__((ext_vector_type(4)));
typedef float f32x4 __attribute__((ext_vector_type(4)));
typedef float f32x8 __attribute__((ext_vector_type(8)));
typedef float f32x16 __attribute__((ext_vector_type(16)));
typedef unsigned u32x4 __attribute__((ext_vector_type(4)));
typedef unsigned u32x2 __attribute__((ext_vector_type(2)));
#define LAS __attribute__((address_space(3)))
#define DI __device__ __forceinline__

constexpr int T = 65536, DM = 1024, TP = 32768;
constexpr float EPS = 1e-6f;
constexpr int NTHREADS = 512;
constexpr int LDS_BYTES = 147456;
constexpr float LAMBDA_INIT1 = 0.35550906759f;
#define REP_ATTN 1
#define REP_SCAN 1
#define REP_GEMM 1

constexpr size_t MiB = 1ull << 20;
constexpr size_t O_WA = 0;
constexpr size_t O_WB = O_WA + 1280ull * 1024 * 2;
constexpr size_t O_WO = O_WB + 3 * MiB;
constexpr size_t O_WAOUT = O_WO + 2 * MiB;
constexpr size_t O_WQKV = O_WAOUT + 2 * MiB;
constexpr size_t O_WBOUT = O_WQKV + 6 * MiB;
constexpr size_t O_LAYER = O_WBOUT + 2 * MiB;
constexpr size_t L_WQG = 0, L_WKV = 2 * MiB, L_WCOUT = 6 * MiB, L_W1 = 8 * MiB, L_W2 = 16 * MiB, L_SIZE = 24 * MiB;
constexpr size_t O_MEMB = O_LAYER + 2 * L_SIZE;
constexpr size_t O_KVM = O_MEMB + 3 * MiB;
constexpr size_t O_MB = O_KVM + 6 * MiB;
constexpr size_t O_NB = O_MB + 12 * MiB;
constexpr size_t O_GATES = O_NB + 12 * MiB;
constexpr size_t O_ROWSS = O_GATES + 4 * MiB;
constexpr size_t O_MISC = O_ROWSS + 8 * MiB;
constexpr size_t O_R1 = O_MISC + 1 * MiB;
constexpr size_t O_R2 = O_R1 + 128 * MiB;
constexpr size_t O_R0 = O_R2 + 128 * MiB;
constexpr size_t WS_END = O_R0 + 128 * MiB;

struct Params { const float* in[24]; float* out; unsigned char* ws; int ph_lo, ph_hi; };

DI unsigned cvt_pk_bf16(float lo, float hi) { unsigned r; asm("v_cvt_pk_bf16_f32 %0, %1, %2" : "=v"(r) : "v"(lo), "v"(hi)); return r; }
DI float bflo(unsigned u) { return __uint_as_float(u << 16); }
DI float bfhi(unsigned u) { return __uint_as_float(u & 0xffff0000u); }
DI float rstd_of(float ss) { return rsqrtf(ss * (1.0f / 1024.0f) + EPS); }
DI float rstd4(const float* ss, int row) { return rstd_of((ss[row] + ss[T + row]) + (ss[2 * T + row] + ss[3 * T + row])); }
DI int lane_id() { return (int)__builtin_amdgcn_mbcnt_hi(~0u, __builtin_amdgcn_mbcnt_lo(~0u, 0u)); }
DI int tid_of(int wv) { return wv * 64 + lane_id(); }
DI int batch_of_row(int row) { return row < TP ? (row >> 14) : 2 + ((row - TP) >> 13); }

namespace pg8 {
constexpr int BM = 256, BK = 64, HALF = 128, HTB = HALF * BK * 2, STAGE_BYTES = 8 * HTB, NXCD = 8, WGM = 8;
DI int lds_byte(int r, int c) { const int st = (r >> 4) * 2 + (c >> 5), rr = r & 15, cc = c & 31, ob = rr * 64 + cc * 2; return st * 1024 + (ob ^ (((ob >> 9) & 1) << 5)); }
DI void stage_rc(int b, int& R, int& C) { const int st = b / 1024, sb = b % 1024, swz = sb ^ (((sb >> 9) & 1) << 5); R = (st >> 1) * 16 + swz / 64; C = (st & 1) * 32 + (swz % 64) / 2; }
DI int perm32(int rho) { const int n = rho >> 4, i = rho & 15; return 8 * (i >> 2) + 4 * n + (i & 3); }

struct Unit { const char* A; const char* B; int row0, col0; size_t coff; };

DI bool static_tile(int i, int G, int c, int nM, int nN, int& pm, int& pn) {
    const int nwg = nM * nN; const long L = (long)i * G + c; if (L >= nwg) return false;
    int wgid = (int)L; { const int q = nwg / NXCD, r = nwg % NXCD, xcd = wgid % NXCD, off = wgid / NXCD; wgid = (xcd < r ? xcd * (q + 1) : r * (q + 1) + (xcd - r) * q) + off; }
    const int nig = WGM * nN, gid = wgid / nig, fm = gid * WGM, gsz = (nM - fm) < WGM ? (nM - fm) : WGM;
    pm = fm + ((wgid % nig) % gsz); pn = (wgid % nig) / gsz; return true;
}
struct Sched {
    int nM, nN, G, c, pm0; const char* A; const char* B; size_t a_tile, b_tile, b_batch;
    DI bool next(int i, Unit& u) const {
        int pm, pn; if (!static_tile(i, G, c, nM, nN, pm, pn)) return false;
        pm += pm0; u.row0 = pm * 256; u.col0 = pn * 256; u.coff = 0;
        u.A = A + (size_t)pm * a_tile; u.B = B + (size_t)pn * b_tile + (b_batch ? (size_t)batch_of_row(u.row0) * b_batch : 0);
        return true;
    }
};
struct SchedM {
    int G, c; const char* kvm; const char* wqg;
    DI bool next(int i, Unit& u) const { const int L = i * G + c; if (L >= 96) return false; const int b = L / 16, h = (L >> 2) & 3, t = L & 3;
        u.A = kvm + ((size_t)b * 256 * 2048 + h * 256) * 2; u.B = wqg + ((size_t)t * 256 * 1024 + h * 256) * 2; u.row0 = h * 256; u.col0 = t * 256; u.coff = (size_t)b * 1024 * 1024; return true; }
};
struct SchedN {
    int G, c; const char* kvm; const char* wc;
    DI bool next(int i, Unit& u) const { const int L = i * G + c; if (L >= 96) return false; const int b = L / 16, h = (L >> 2) & 3, t = L & 3;
        u.A = wc + ((size_t)t * 256 * 1024 + h * 256) * 2; u.B = kvm + ((size_t)b * 256 * 2048 + 1024 + h * 256) * 2; u.row0 = t * 256; u.col0 = h * 256; u.coff = (size_t)b * 1024 * 1024; return true; }
};

typedef f32x4 Acc[2][2][4][2];

template <bool MAX> DI void row_allreduce(float (&v)[8], LAS float* st, int wr, int wc, int fr, int fq) {
#pragma unroll
    for (int i = 0; i < 8; ++i) {
        float a = __shfl_xor(v[i], 16), b;
        v[i] = MAX ? fmaxf(v[i], a) : v[i] + a;
        b = __shfl_xor(v[i], 32);
        v[i] = MAX ? fmaxf(v[i], b) : v[i] + b;
    }
    if (fq == 0) {
#pragma unroll
        for (int i = 0; i < 8; ++i) st[((i >> 2) * 128 + wr * 64 + (i & 3) * 16 + fr) * 4 + wc] = v[i];
    }
    __syncthreads();
#pragma unroll
    for (int i = 0; i < 8; ++i) { const f32x4 x = *(const LAS f32x4*)&st[((i >> 2) * 128 + wr * 64 + (i & 3) * 16 + fr) * 4];
        v[i] = MAX ? fmaxf(fmaxf(x[0], x[1]), fmaxf(x[2], x[3])) : (x[0] + x[1]) + (x[2] + x[3]); }
}
DI void st_bf16x8(bf16_t* p, f32x4 v0, f32x4 v1) { u32x4 w; w.x = cvt_pk_bf16(v0[0], v0[1]); w.y = cvt_pk_bf16(v0[2], v0[3]); w.z = cvt_pk_bf16(v1[0], v1[1]); w.w = cvt_pk_bf16(v1[2], v1[3]); *(u32x4*)p = w; }

struct EpiPlain { bf16_t* O; int ldc; const float* ss;
    DI void operator()(const Acc& acc, const Unit& u, int wr, int wc, int fr, int fq, LAS float*) const {
        const int r0 = u.row0 + wr * 64 + fr, c0 = u.col0 + wc * 32 + 8 * fq;
#pragma unroll
        for (int ai = 0; ai < 2; ++ai)
#pragma unroll
            for (int m = 0; m < 4; ++m) { const int row = r0 + ai * 128 + m * 16; const float sc = ss ? rstd_of(ss[row]) : 1.0f;
                bf16_t* rp = O + u.coff + (size_t)row * ldc + c0;
#pragma unroll
                for (int bj = 0; bj < 2; ++bj) st_bf16x8(rp + bj * 128, acc[ai][bj][m][0] * sc, acc[ai][bj][m][1] * sc); }
    } };
struct EpiQKVh { bf16_t* O; const float* ss; int rowbase;
    DI void operator()(const Acc& acc, const Unit& u, int wr, int wc, int fr, int fq, LAS float*) const {
        const int r0 = u.row0 + wr * 64 + fr, ph0 = u.col0 >> 7;
#pragma unroll
        for (int ai = 0; ai < 2; ++ai)
#pragma unroll
            for (int m = 0; m < 4; ++m) { const int row = r0 + ai * 128 + m * 16; const float sc = rstd4(ss, row);
#pragma unroll
                for (int bj = 0; bj < 2; ++bj) st_bf16x8(O + ((size_t)(ph0 + bj) * TP + (row - rowbase)) * 128 + wc * 32 + 8 * fq, acc[ai][bj][m][0] * sc, acc[ai][bj][m][1] * sc); }
    } };
struct EpiColScale { bf16_t* O; int ldc; const float* ss;
    DI void operator()(const Acc& acc, const Unit& u, int wr, int wc, int fr, int fq, LAS float*) const {
        const int r0 = u.row0 + wr * 64 + fr, c0 = u.col0 + wc * 32 + 8 * fq;
        f32x4 s[2][2];
#pragma unroll
        for (int bj = 0; bj < 2; ++bj)
#pragma unroll
            for (int n = 0; n < 2; ++n) { const float* sp = ss + c0 + bj * 128 + n * 4; const f32x4 x = (*(const f32x4*)sp + *(const f32x4*)(sp + T)) + (*(const f32x4*)(sp + 2 * T) + *(const f32x4*)(sp + 3 * T)); s[bj][n] = (f32x4){rstd_of(x[0]), rstd_of(x[1]), rstd_of(x[2]), rstd_of(x[3])}; }
#pragma unroll
        for (int ai = 0; ai < 2; ++ai)
#pragma unroll
            for (int m = 0; m < 4; ++m) { const int row = r0 + ai * 128 + m * 16;
#pragma unroll
                for (int bj = 0; bj < 2; ++bj) st_bf16x8(O + ((size_t)((u.col0 >> 7) + bj) * 1536 + row) * 128 + wc * 32 + 8 * fq, acc[ai][bj][m][0] * s[bj][0], acc[ai][bj][m][1] * s[bj][1]); }
    } };
DI float logsigmoid(float x) { return fminf(x, 0.f) - log1pf(__expf(-fabsf(x))); }
struct EpiQKG { bf16_t* Q; bf16_t* K; float* gates; const float* bg; const float* ss;
    DI void operator()(const Acc& acc, const Unit& u, int wr, int wc, int fr, int fq, LAS float*) const {
        const int r0 = u.row0 + wr * 64 + fr, c0 = u.col0 + wc * 32 + 8 * fq;
        if (u.col0 < 1024) {
            bf16_t* base = ((u.col0 < 512) ? Q : K) + wc * 32 + 8 * fq; const int h0 = (u.col0 & 511) >> 7;
#pragma unroll
            for (int ai = 0; ai < 2; ++ai)
#pragma unroll
                for (int m = 0; m < 4; ++m) { const int row = r0 + ai * 128 + m * 16; const float sc = rstd4(ss, row);
#pragma unroll
                    for (int bj = 0; bj < 2; ++bj) st_bf16x8(base + ((size_t)(h0 + bj) * T + row) * 128, acc[ai][bj][m][0] * sc, acc[ai][bj][m][1] * sc); }
        } else if (wc == 0 && fq < 2) {
            const int j0 = 8 * fq;
            float b[8];
#pragma unroll
            for (int j = 0; j < 8; ++j) b[j] = bg[j0 + j];
#pragma unroll
            for (int ai = 0; ai < 2; ++ai)
#pragma unroll
                for (int m = 0; m < 4; ++m) { const int row = r0 + ai * 128 + m * 16; const float sc = rstd4(ss, row);
                    float v[8];
#pragma unroll
                    for (int j = 0; j < 8; ++j) { v[j] = acc[ai][0][m][j >> 2][j & 3] * sc + b[j]; }
#pragma unroll
                    for (int j = 4; j < 8; ++j) v[j] = logsigmoid(v[j]);
                    float* gp = gates + (size_t)row * 16 + j0;
                    *(f32x4*)gp = (f32x4){v[0], v[1], v[2], v[3]}; *(f32x4*)(gp + 4) = (f32x4){v[4], v[5], v[6], v[7]}; }
        }
    } };
struct EpiOGate { bf16_t* HF; const bf16_t* HB; const float* ng; const float* ss;
    DI void operator()(const Acc& acc, const Unit& u, int wr, int wc, int fr, int fq, LAS float* st) const {
        const int r0 = u.row0 + wr * 64 + fr, c0 = u.col0 + wc * 32 + 8 * fq;
        float hs[8];
#pragma unroll
        for (int i = 0; i < 8; ++i) { const int row = r0 + (i >> 2) * 128 + (i & 3) * 16; float s = 0.f;
#pragma unroll
            for (int bj = 0; bj < 2; ++bj) { const u32x4 a = *(const u32x4*)(HF + (size_t)row * 1024 + c0 + bj * 128), b = *(const u32x4*)(HB + (size_t)row * 1024 + c0 + bj * 128);
#pragma unroll
                for (int k = 0; k < 4; ++k) { const float x = bflo(a[k]) + bflo(b[k]), y = bfhi(a[k]) + bfhi(b[k]); s += x * x + y * y; } }
            hs[i] = s; }
        row_allreduce<false>(hs, st, wr, wc, fr, fq);
        float g[2][8];
#pragma unroll
        for (int bj = 0; bj < 2; ++bj) { const f32x4 x = *(const f32x4*)(ng + c0 + bj * 128), y = *(const f32x4*)(ng + c0 + bj * 128 + 4);
            g[bj][0] = x[0]; g[bj][1] = x[1]; g[bj][2] = x[2]; g[bj][3] = x[3]; g[bj][4] = y[0]; g[bj][5] = y[1]; g[bj][6] = y[2]; g[bj][7] = y[3]; }
#pragma unroll
        for (int i = 0; i < 8; ++i) { const int ai = i >> 2, m = i & 3, row = r0 + ai * 128 + m * 16; const float sc = rstd4(ss, row), hn = rsqrtf(hs[i] * (1.0f / 256.0f) + EPS);
#pragma unroll
            for (int bj = 0; bj < 2; ++bj) { bf16_t* hp = HF + (size_t)row * 1024 + c0 + bj * 128; const u32x4 a = *(const u32x4*)hp, b = *(const u32x4*)(HB + (size_t)row * 1024 + c0 + bj * 128);
                float o[8];
#pragma unroll
                for (int k = 0; k < 4; ++k) { o[2 * k] = bflo(a[k]) + bflo(b[k]); o[2 * k + 1] = bfhi(a[k]) + bfhi(b[k]); }
#pragma unroll
                for (int k = 0; k < 8; ++k) { const float z = acc[ai][bj][m][k >> 2][k & 3] * sc; o[k] = o[k] * hn * g[bj][k] * (1.0f / (1.0f + __expf(-z))); }
                st_bf16x8(hp, (f32x4){o[0], o[1], o[2], o[3]}, (f32x4){o[4], o[5], o[6], o[7]}); } }
    } };
template <int MODE> struct EpiRes { const float* xlo; const float* xhi; float* out; bf16_t* xb; float* ssout;
    DI void operator()(const Acc& acc, const Unit& u, int wr, int wc, int fr, int fq, LAS float* st) const {
        const int r0 = u.row0 + wr * 64 + fr, c0 = u.col0 + wc * 32 + 8 * fq;
        const float* xo = (u.row0 < TP) ? xlo : xhi - (size_t)TP * 1024;
        float sv[8];
#pragma unroll
        for (int ai = 0; ai < 2; ++ai)
#pragma unroll
            for (int m = 0; m < 4; ++m) { const int row = r0 + ai * 128 + m * 16; float s = 0.f;
#pragma unroll
                for (int bj = 0; bj < 2; ++bj) { const size_t off = (size_t)row * 1024 + c0 + bj * 128;
                    f32x4 v0, v1;
                    if (MODE == 0) { v0 = *(const f32x4*)(xo + off); v1 = *(const f32x4*)(xo + off + 4); }
                    else { const u32x4 w = *(const u32x4*)(xb + off); v0 = (f32x4){bflo(w.x), bfhi(w.x), bflo(w.y), bfhi(w.y)}; v1 = (f32x4){bflo(w.z), bfhi(w.z), bflo(w.w), bfhi(w.w)}; }
                    v0 += acc[ai][bj][m][0]; v1 += acc[ai][bj][m][1];
                    if (MODE == 2) { *(f32x4*)(out + off) = v0; *(f32x4*)(out + off + 4) = v1; } else st_bf16x8(xb + off, v0, v1);
                    s += v0[0] * v0[0] + v0[1] * v0[1] + v0[2] * v0[2] + v0[3] * v0[3] + v1[0] * v1[0] + v1[1] * v1[1] + v1[2] * v1[2] + v1[3] * v1[3]; }
                sv[ai * 4 + m] = s; }
        row_allreduce<false>(sv, st, wr, wc, fr, fq);
        if (fq == 0 && wc == 0) {
#pragma unroll
            for (int i = 0; i < 8; ++i) ssout[(size_t)(u.col0 >> 8) * T + r0 + (i >> 2) * 128 + (i & 3) * 16] = sv[i]; }
    } };
struct EpiSoftmax { bf16_t* P; const float* ss;
    DI void operator()(Acc& acc, const Unit& u, int wr, int wc, int fr, int fq, LAS float* st) const {
        const int r0 = u.row0 + wr * 64 + fr, c0 = u.col0 + wc * 32 + 8 * fq;
        float mx[8], sm[8];
#pragma unroll
        for (int i = 0; i < 8; ++i) { const int ai = i >> 2, m = i & 3; const float sc = rstd4(ss, r0 + ai * 128 + m * 16) * 1.4426950408889634f; float x = -3.0e38f;
#pragma unroll
            for (int bj = 0; bj < 2; ++bj)
#pragma unroll
                for (int n = 0; n < 2; ++n) { acc[ai][bj][m][n] *= sc;
#pragma unroll
                    for (int k = 0; k < 4; ++k) x = fmaxf(x, acc[ai][bj][m][n][k]); }
            mx[i] = x; }
        row_allreduce<true>(mx, st, wr, wc, fr, fq);
#pragma unroll
        for (int i = 0; i < 8; ++i) { const int ai = i >> 2, m = i & 3; float s = 0.f;
#pragma unroll
            for (int bj = 0; bj < 2; ++bj)
#pragma unroll
                for (int n = 0; n < 2; ++n)
#pragma unroll
                    for (int k = 0; k < 4; ++k) { const float e = __builtin_amdgcn_exp2f(acc[ai][bj][m][n][k] - mx[i]); acc[ai][bj][m][n][k] = e; s += e; }
            sm[i] = s; }
        row_allreduce<false>(sm, st + 1024, wr, wc, fr, fq);
#pragma unroll
        for (int i = 0; i < 8; ++i) { const int ai = i >> 2, m = i & 3, row = r0 + ai * 128 + m * 16; const float inv = 1.0f / sm[i];
#pragma unroll
            for (int bj = 0; bj < 2; ++bj) st_bf16x8(P + (size_t)row * 1024 + c0 + bj * 128, acc[ai][bj][m][0] * inv, acc[ai][bj][m][1] * inv); }
    } };
struct EpiSqRelu { bf16_t* O; int ldc; const float* ss; int rowbase;
    DI void operator()(const Acc& acc, const Unit& u, int wr, int wc, int fr, int fq, LAS float*) const {
        const int r0 = u.row0 + wr * 64 + fr, c0 = u.col0 + wc * 32 + 8 * fq;
#pragma unroll
        for (int ai = 0; ai < 2; ++ai)
#pragma unroll
            for (int m = 0; m < 4; ++m) { const int row = r0 + ai * 128 + m * 16; const float sc = rstd4(ss, row);
                bf16_t* rp = O + (size_t)(row - rowbase) * ldc + c0;
#pragma unroll
                for (int bj = 0; bj < 2; ++bj) { f32x4 v0 = acc[ai][bj][m][0] * sc, v1 = acc[ai][bj][m][1] * sc;
#pragma unroll
                    for (int k = 0; k < 4; ++k) { const float a = fmaxf(v0[k], 0.f), b = fmaxf(v1[k], 0.f); v0[k] = a * a; v1[k] = b * b; }
                    st_bf16x8(rp + bj * 128, v0, v1); } }
    } };

template <class Epi, class SchedT>
__device__ __forceinline__ void gemm_phase(LAS unsigned char* lds, int K, int lda, int ldb, const SchedT& S, const Epi& E, int wv) {
    int tid = tid_of(wv); asm volatile("" : "+v"(tid));
    const int wid = __builtin_amdgcn_readfirstlane(tid >> 6), lane = tid & 63, wr = wid >> 2, wc = wid & 3, fr = lane & 15, fq = lane >> 4;
    const int nt = K / BK;
    LAS float* stats = (LAS float*)(lds + STAGE_BYTES);
    unsigned voffA[2], voffB[2];
#pragma unroll
    for (int i = 0; i < 2; ++i) { int R, C; stage_rc(tid * 16 + i * 8192, R, C); const int Rb = (R & ~31) + perm32(R & 31);
        voffA[i] = (unsigned)(R * lda + C) * 2u; voffB[i] = (unsigned)(Rb * ldb + C) * 2u; }
    const size_t kstep = (size_t)(BK * 2);
    const size_t hstepA = (size_t)HALF * lda * 2, hstepB = (size_t)HALF * ldb * 2;
    const unsigned ldsw = (unsigned)wid * 1024u;
    const int aoff = lds_byte(wr * 64 + fr, fq * 8), boff = lds_byte(wc * 32 + fr, fq * 8);
#define PG8_SA(b, h) (((b) * 2 + (h)) * HTB)
#define PG8_SB(b, h) ((4 + (b) * 2 + (h)) * HTB)
#define PG8_STAGE(bufoff, gbase, voff) do { _Pragma("unroll") for (int _i = 0; _i < 2; ++_i) \
        __builtin_amdgcn_global_load_lds((const unsigned*)((const char*)(gbase) + (voff)[_i]), (LAS unsigned*)(lds + (bufoff) + ldsw + _i * 8192), 16, 0, 0); } while (0)
#define PG8_LDA(dst, b, h) do { _Pragma("unroll") for (int m = 0; m < 4; ++m) _Pragma("unroll") for (int k = 0; k < 2; ++k) dst[m][k] = *(const LAS bf16x8*)(lds + PG8_SA(b, h) + aoff + m * 2048 + k * 1024); } while (0)
#define PG8_LDB(dst, b, h) do { _Pragma("unroll") for (int n = 0; n < 2; ++n) _Pragma("unroll") for (int k = 0; k < 2; ++k) dst[n][k] = *(const LAS bf16x8*)(lds + PG8_SB(b, h) + boff + n * 2048 + k * 1024); } while (0)
#define PG8_MMA(ai, bj, At, Bt) do { __builtin_amdgcn_s_setprio(1); _Pragma("unroll") for (int m = 0; m < 4; ++m) _Pragma("unroll") for (int n = 0; n < 2; ++n) _Pragma("unroll") for (int k = 0; k < 2; ++k) \
        acc[ai][bj][m][n] = __builtin_amdgcn_mfma_f32_16x16x32_bf16(Bt[n][k], At[m][k], acc[ai][bj][m][n], 0, 0, 0); __builtin_amdgcn_s_setprio(0); } while (0)
#define PG8_WAIT_V(n) asm volatile("s_waitcnt vmcnt(" #n ")" ::: "memory")
#define PG8_WAIT_L(n) asm volatile("s_waitcnt lgkmcnt(" #n ")" ::: "memory")
#define PG8_BAR __builtin_amdgcn_s_barrier()
#define PG8_SCHED __builtin_amdgcn_sched_barrier(0)
    Unit cur, nxt; int ui = 0;
    if (!S.next(0, cur)) return;
    Acc acc;
#pragma unroll
    for (int a = 0; a < 2; ++a)
#pragma unroll
        for (int b = 0; b < 2; ++b)
#pragma unroll
            for (int m = 0; m < 4; ++m)
#pragma unroll
                for (int n = 0; n < 2; ++n) acc[a][b][m][n] = (f32x4){0.f, 0.f, 0.f, 0.f};
    bf16x8 At[4][2], B0[2][2], B1[2][2];
    const char* cA = cur.A; const char* cB = cur.B;
    PG8_STAGE(PG8_SB(0, 0), cB, voffB); PG8_STAGE(PG8_SA(0, 0), cA, voffA); PG8_STAGE(PG8_SB(0, 1), cB + hstepB, voffB); PG8_STAGE(PG8_SA(0, 1), cA + hstepA, voffA);
    if (wr == 1) PG8_BAR;
    PG8_WAIT_V(4); PG8_BAR;
    PG8_STAGE(PG8_SB(1, 0), cB + kstep, voffB); PG8_STAGE(PG8_SA(1, 0), cA + kstep, voffA); PG8_STAGE(PG8_SB(1, 1), cB + hstepB + kstep, voffB);
    PG8_WAIT_V(6); PG8_BAR;
    for (;;) {
        const bool has_next = S.next(ui + 1, nxt);
        const char* nA = has_next ? nxt.A : cA; const char* nB = has_next ? nxt.B : cB;
        for (int t = 0; t < nt; t += 2) {
            const bool last = (t == nt - 2);
            const char* a1 = cA + (size_t)(t + 1) * kstep;
            const char* a2 = last ? nA : cA + (size_t)(t + 2) * kstep; const char* b2 = last ? nB : cB + (size_t)(t + 2) * kstep;
            const char* a3 = a2 + kstep; const char* b3 = b2 + kstep;
            PG8_LDB(B0, 0, 0); PG8_SCHED; PG8_LDA(At, 0, 0); PG8_STAGE(PG8_SA(1, 1), a1 + hstepA, voffA);
            PG8_WAIT_L(8); PG8_BAR; PG8_WAIT_L(0); PG8_MMA(0, 0, At, B0); PG8_BAR; PG8_SCHED;
            PG8_LDB(B1, 0, 1); PG8_STAGE(PG8_SB(0, 0), b2, voffB);
            PG8_BAR; PG8_WAIT_L(0); PG8_MMA(0, 1, At, B1); PG8_BAR;
            PG8_LDA(At, 0, 1); PG8_STAGE(PG8_SA(0, 0), a2, voffA);
            PG8_BAR; PG8_WAIT_L(0); PG8_MMA(1, 0, At, B0); PG8_BAR; PG8_SCHED;
            PG8_STAGE(PG8_SB(0, 1), b2 + hstepB, voffB);
            PG8_WAIT_V(6); PG8_BAR; PG8_MMA(1, 1, At, B1); PG8_BAR;
            PG8_LDB(B0, 1, 0); PG8_SCHED; PG8_LDA(At, 1, 0); PG8_STAGE(PG8_SA(0, 1), a2 + hstepA, voffA);
            PG8_WAIT_L(8); PG8_BAR; PG8_WAIT_L(0); PG8_MMA(0, 0, At, B0); PG8_BAR; PG8_SCHED;
            PG8_LDB(B1, 1, 1); PG8_STAGE(PG8_SB(1, 0), b3, voffB);
            PG8_BAR; PG8_WAIT_L(0); PG8_MMA(0, 1, At, B1); PG8_BAR;
            PG8_LDA(At, 1, 1); PG8_STAGE(PG8_SA(1, 0), a3, voffA);
            PG8_BAR; PG8_WAIT_L(0); PG8_MMA(1, 0, At, B0); PG8_BAR; PG8_SCHED;
            PG8_STAGE(PG8_SB(1, 1), b3 + hstepB, voffB);
            PG8_WAIT_V(6); PG8_BAR; PG8_MMA(1, 1, At, B1); PG8_BAR;
        }
        E(acc, cur, wr, wc, fr, fq, stats);
        if (!has_next) break;
#pragma unroll
        for (int a = 0; a < 2; ++a)
#pragma unroll
            for (int b = 0; b < 2; ++b)
#pragma unroll
                for (int m = 0; m < 4; ++m)
#pragma unroll
                    for (int n = 0; n < 2; ++n) acc[a][b][m][n] = (f32x4){0.f, 0.f, 0.f, 0.f};
        cur = nxt; cA = nA; cB = nB; ++ui;
    }
    PG8_WAIT_V(0);
    if (wr == 0) PG8_BAR;
    PG8_BAR;
#undef PG8_SA
#undef PG8_SB
#undef PG8_STAGE
#undef PG8_LDA
#undef PG8_LDB
#undef PG8_MMA
#undef PG8_WAIT_V
#undef PG8_WAIT_L
#undef PG8_BAR
#undef PG8_SCHED
}
}

struct CvtJob { const float* src; int lds_src, col0, K, N, nvalid; const float* g; bf16_t* dst; int ldd; int sn0, sn1; float sscale; };
DI void cvt_tile(const CvtJob& J, int tile, LAS float* tl, int wv) {
    const int tid = tid_of(wv), nkt = J.K / 64, kt = tile % nkt, ntile = tile / nkt, k0 = kt * 64, n0 = ntile * 64;
    { const int kr = tid >> 4, nc = (tid & 15) * 4;
#pragma unroll
      for (int i = 0; i < 2; ++i) { const int k = k0 + kr + 32 * i; f32x4 v = (f32x4){0.f, 0.f, 0.f, 0.f};
          if (n0 + nc < J.nvalid) v = *(const f32x4*)(J.src + (size_t)k * J.lds_src + J.col0 + n0 + nc);
          float s = J.g ? J.g[k] : 1.0f; if (n0 + nc >= J.sn0 && n0 + nc < J.sn1) s *= J.sscale;
#pragma unroll
          for (int j = 0; j < 4; ++j) tl[(kr + 32 * i) * 65 + nc + j] = v[j] * s; } }
    __syncthreads();
    { const int n = tid >> 3, kq = (tid & 7) * 8; float v[8];
#pragma unroll
      for (int j = 0; j < 8; ++j) v[j] = tl[(kq + j) * 65 + n];
      pg8::st_bf16x8(J.dst + (size_t)(n0 + n) * J.ldd + k0 + kq, (f32x4){v[0], v[1], v[2], v[3]}, (f32x4){v[4], v[5], v[6], v[7]}); }
    __syncthreads();
}
DI int cvt_tiles(const CvtJob& J) { return (J.K / 64) * (J.N / 64); }

DI void rows_to_bf16(const float* xlo, const float* xhi, int nrows, int split, bf16_t* dst, float* ss, int gw, int nw, bool slots4) {
    const int lane = lane_id();
    for (int row = gw; row < nrows; row += nw) {
        const float* src = (row < split) ? xlo + (size_t)row * 1024 : xhi + (size_t)(row - split) * 1024;
        float s = 0.f;
#pragma unroll
        for (int i = 0; i < 4; ++i) { const f32x4 v = *(const f32x4*)(src + i * 256 + lane * 4);
            s += v[0] * v[0] + v[1] * v[1] + v[2] * v[2] + v[3] * v[3];
            u32x2 w; w.x = cvt_pk_bf16(v[0], v[1]); w.y = cvt_pk_bf16(v[2], v[3]); *(u32x2*)(dst + (size_t)row * 1024 + i * 256 + lane * 4) = w; }
        if (ss) {
#pragma unroll
            for (int o = 32; o >= 1; o >>= 1) s += __shfl_xor(s, o);
            if (lane == 0) { ss[row] = s; if (slots4) { ss[T + row] = 0.f; ss[2 * T + row] = 0.f; ss[3 * T + row] = 0.f; } } }
    }
}
DI int rel_bucket(int rp) {
    const int ret = rp > 0 ? 16 : 0; const int n = rp < 0 ? -rp : rp; const float nf = (float)(n > 1 ? n : 1);
    int large = 8 + (int)(logf(nf / 8.0f) / 2.772588722239781f * 8.0f); large = large < 15 ? large : 15;
    return ret + (n < 8 ? n : large);
}

namespace scan {
constexpr int LD = 136;
constexpr int O_Q = 0, O_K = 34816, O_KT = 69632, O_VT = 104448, O_CT = 121856, O_F = 139264;
DI bf16x8 rev8(bf16x8 v) { return (bf16x8){v[7], v[6], v[5], v[4], v[3], v[2], v[1], v[0]}; }
#define MFMA16(a, b, c) __builtin_amdgcn_mfma_f32_16x16x32_bf16((a), (b), (c), 0, 0, 0)

__device__ __forceinline__ void run(const Params& p, LAS unsigned char* lds, int item, int wv) {
    int tid = tid_of(wv); asm volatile("" : "+v"(tid));
    const int wid = __builtin_amdgcn_readfirstlane(tid >> 6), lane = tid & 63, fr = lane & 15, fq = lane >> 4;
    const int seq = item >> 5, rem = item & 31, h = rem >> 3, dir = (rem >> 2) & 1, slice = rem & 3;
    const int S = seq < 2 ? 16384 : 8192, seq0 = seq < 2 ? seq * 16384 : TP + (seq - 2) * 8192, nc = S / 128;
    const bf16_t* Qg = (const bf16_t*)(p.ws + O_R1) + (size_t)h * T * 128;
    const bf16_t* Kg = (const bf16_t*)(p.ws + O_R1 + 64 * MiB) + (size_t)h * T * 128;
    const bf16_t* KTg = (const bf16_t*)p.out + (size_t)(h * 128) * 128;
    const bf16_t* VTg = (const bf16_t*)p.out + (size_t)(512 + h * 256 + slice * 64) * 128;
    const float* gates = (const float*)(p.ws + O_GATES);
    bf16_t* Hg = (bf16_t*)(p.ws + (dir ? O_R0 : O_R2)) + h * 256 + slice * 64;
    LAS bf16_t* sQ = (LAS bf16_t*)(lds + O_Q); LAS bf16_t* sK = (LAS bf16_t*)(lds + O_K); LAS bf16_t* sKt = (LAS bf16_t*)(lds + O_KT);
    LAS bf16_t* sVt = (LAS bf16_t*)(lds + O_VT); LAS bf16_t* sCt = (LAS bf16_t*)(lds + O_CT);
    LAS float* F = (LAS float*)(lds + O_F);
    LAS float *gA = F, *MA = F + 128, *iwA = F + 256, *emA = F + 384, *wA = F + 512, *qnA = F + 640, *nvA = F + 768, *dinvA = F + 896, *rawig = F + 1024, *rawlf = F + 1152, *denp = F + 1280, *scal = F + 1792;
    for (int i = tid; i < 64 * LD / 2; i += NTHREADS) ((LAS unsigned*)sCt)[i] = 0u;
    if (tid < 128) nvA[tid] = 0.f;
    float m_state = 0.f;
    f32x4 cacc[2][2];
#pragma unroll
    for (int a = 0; a < 2; ++a)
#pragma unroll
        for (int b = 0; b < 2; ++b) cacc[a][b] = (f32x4){0.f, 0.f, 0.f, 0.f};
    bf16x8 pq[4], pk[4], pkt[4], pvt[2]; float pig = 0.f, plf = 0.f;
    const int igc = dir * 8 + h, lfc = dir * 8 + 4 + h;
#define SC_PREFETCH(cc) do { const int base = seq0 + (dir ? S - 128 - (cc) * 128 : (cc) * 128); \
        _Pragma("unroll") for (int k = 0; k < 4; ++k) { const int pp = tid + 512 * k, r = pp >> 4, c8 = (pp & 15) * 8; const size_t tok = (size_t)(base + (dir ? 127 - r : r)); \
            pq[k] = *(const bf16x8*)(Qg + tok * 128 + c8); pk[k] = *(const bf16x8*)(Kg + tok * 128 + c8); \
            pkt[k] = *(const bf16x8*)(KTg + ((size_t)(base >> 7) * 1536 + r) * 128 + (dir ? 120 - c8 : c8)); } \
        _Pragma("unroll") for (int k = 0; k < 2; ++k) { const int pp = tid + 512 * k, r = pp >> 4, c8 = (pp & 15) * 8; \
            pvt[k] = *(const bf16x8*)(VTg + ((size_t)(base >> 7) * 1536 + r) * 128 + (dir ? 120 - c8 : c8)); } \
        if (tid < 128) { const size_t tok = (size_t)(base + (dir ? 127 - tid : tid)); pig = gates[tok * 16 + igc]; plf = gates[tok * 16 + lfc]; } } while (0)
    SC_PREFETCH(0);
    for (int cc = 0; cc < nc; ++cc) {
        const int base = seq0 + (dir ? S - 128 - cc * 128 : cc * 128);
        if (tid < 128) { rawig[tid] = pig; rawlf[tid] = plf; }
        __syncthreads();
        if (wid == 0) {
            const float x0 = rawlf[2 * lane], x1 = rawlf[2 * lane + 1], i0 = rawig[2 * lane], i1 = rawig[2 * lane + 1];
            const float s = x0 + x1; float incl = s;
#pragma unroll
            for (int o = 1; o < 64; o <<= 1) { const float t = __shfl_up(incl, o); if (lane >= o) incl += t; }
            const float b0 = incl - s + x0, b1 = incl;
            const float g0 = i0 - b0, g1 = i1 - b1; float im = fmaxf(g0, g1);
#pragma unroll
            for (int o = 1; o < 64; o <<= 1) { const float t = __shfl_up(im, o); if (lane >= o) im = fmaxf(im, t); }
            float em_ = __shfl_up(im, 1); if (lane == 0) em_ = -3.0e38f;
            const float M0 = fmaxf(m_state, fmaxf(em_, g0)), M1 = fmaxf(m_state, im);
            const float Ml = __shfl(M1, 63), bl = __shfl(b1, 63);
            gA[2 * lane] = g0; gA[2 * lane + 1] = g1; MA[2 * lane] = M0; MA[2 * lane + 1] = M1;
            iwA[2 * lane] = __expf(m_state - M0); iwA[2 * lane + 1] = __expf(m_state - M1);
            emA[2 * lane] = __expf(-(b0 + M0)); emA[2 * lane + 1] = __expf(-(b1 + M1));
            wA[2 * lane] = __expf(g0 - Ml); wA[2 * lane + 1] = __expf(g1 - Ml);
            if (lane == 0) scal[0] = __expf(m_state - Ml);
            m_state = bl + Ml;
        }
        __syncthreads();
#pragma unroll
        for (int k = 0; k < 4; ++k) { const int pp = tid + 512 * k, r = pp >> 4, c8 = (pp & 15) * 8;
            *(LAS bf16x8*)(sQ + r * LD + c8) = pq[k]; *(LAS bf16x8*)(sK + r * LD + c8) = pk[k];
            bf16x8 v = dir ? rev8(pkt[k]) : pkt[k]; const f32x4 w0 = *(const LAS f32x4*)(wA + c8), w1 = *(const LAS f32x4*)(wA + c8 + 4);
            u32x4 o; o.x = cvt_pk_bf16(bflo((unsigned)(unsigned short)v[0]) * w0[0], bflo((unsigned)(unsigned short)v[1]) * w0[1]);
            o.y = cvt_pk_bf16(bflo((unsigned)(unsigned short)v[2]) * w0[2], bflo((unsigned)(unsigned short)v[3]) * w0[3]);
            o.z = cvt_pk_bf16(bflo((unsigned)(unsigned short)v[4]) * w1[0], bflo((unsigned)(unsigned short)v[5]) * w1[1]);
            o.w = cvt_pk_bf16(bflo((unsigned)(unsigned short)v[6]) * w1[2], bflo((unsigned)(unsigned short)v[7]) * w1[3]);
            *(LAS u32x4*)(sKt + r * LD + c8) = o; }
#pragma unroll
        for (int k = 0; k < 2; ++k) { const int pp = tid + 512 * k, r = pp >> 4, c8 = (pp & 15) * 8; *(LAS bf16x8*)(sVt + r * LD + c8) = dir ? rev8(pvt[k]) : pvt[k]; }
        __syncthreads();
        const int sblk = (wid & 3) * 32, tblk = (wid >> 2) * 64, tb = (wid & 3) * 32, eb = (wid >> 2) * 32;
        f32x4 sacc[2][4], nacc[2][2];
#pragma unroll
        for (int a = 0; a < 2; ++a) {
#pragma unroll
            for (int b = 0; b < 4; ++b) sacc[a][b] = (f32x4){0.f, 0.f, 0.f, 0.f};
#pragma unroll
            for (int b = 0; b < 2; ++b) nacc[a][b] = (f32x4){0.f, 0.f, 0.f, 0.f}; }
#pragma unroll 1
        for (int kk = 0; kk < 4; ++kk) { const int ko = kk * 32 + fq * 8;
            bf16x8 ka[2], qb[4], qa[2], cb[2];
#pragma unroll
            for (int a = 0; a < 2; ++a) { ka[a] = *(const LAS bf16x8*)(sK + (sblk + a * 16 + fr) * LD + ko); qa[a] = *(const LAS bf16x8*)(sQ + (tb + a * 16 + fr) * LD + ko); cb[a] = *(const LAS bf16x8*)(sCt + (eb + a * 16 + fr) * LD + ko); }
#pragma unroll
            for (int b = 0; b < 4; ++b) qb[b] = *(const LAS bf16x8*)(sQ + (tblk + b * 16 + fr) * LD + ko);
#pragma unroll
            for (int a = 0; a < 2; ++a) {
#pragma unroll
                for (int b = 0; b < 4; ++b) sacc[a][b] = MFMA16(ka[a], qb[b], sacc[a][b]);
#pragma unroll
                for (int b = 0; b < 2; ++b) nacc[a][b] = MFMA16(qa[a], cb[b], nacc[a][b]); } }
        { const int t = tid >> 2, part = tid & 3; float s = 0.f;
#pragma unroll
          for (int k = 0; k < 4; ++k) { const u32x4 qv = *(const LAS u32x4*)(sQ + t * LD + part * 32 + k * 8); const f32x4 n0 = *(const LAS f32x4*)(nvA + part * 32 + k * 8), n1 = *(const LAS f32x4*)(nvA + part * 32 + k * 8 + 4);
              s += bflo(qv.x) * n0[0] + bfhi(qv.x) * n0[1] + bflo(qv.y) * n0[2] + bfhi(qv.y) * n0[3] + bflo(qv.z) * n1[0] + bfhi(qv.z) * n1[1] + bflo(qv.w) * n1[2] + bfhi(qv.w) * n1[3]; }
          s += __shfl_xor(s, 1); s += __shfl_xor(s, 2); if (part == 0) qnA[t] = s; }
        if (cc + 1 < nc) SC_PREFETCH(cc + 1);
        {
            float gv[2][4];
#pragma unroll
            for (int a = 0; a < 2; ++a) { const f32x4 x = *(const LAS f32x4*)(gA + sblk + a * 16 + 4 * fq); gv[a][0] = x[0]; gv[a][1] = x[1]; gv[a][2] = x[2]; gv[a][3] = x[3]; }
#pragma unroll
            for (int b = 0; b < 4; ++b) { const int t = tblk + b * 16 + fr; const float Mt = MA[t]; float rs = 0.f;
#pragma unroll
                for (int a = 0; a < 2; ++a)
#pragma unroll
                    for (int r = 0; r < 4; ++r) { const int sp = sblk + a * 16 + 4 * fq + r; const float e = (sp <= t) ? __expf(gv[a][r] - Mt) : 0.f; const float pv = sacc[a][b][r] * e; sacc[a][b][r] = pv; rs += pv; }
                rs += __shfl_xor(rs, 16); rs += __shfl_xor(rs, 32);
                if (fq == 0) denp[(wid & 3) * 128 + t] = rs; }
        }
        __syncthreads();
#pragma unroll
        for (int a = 0; a < 2; ++a)
#pragma unroll
            for (int b = 0; b < 4; ++b) { u32x2 w; w.x = cvt_pk_bf16(sacc[a][b][0], sacc[a][b][1]); w.y = cvt_pk_bf16(sacc[a][b][2], sacc[a][b][3]);
                *(LAS u32x2*)(sK + (tblk + b * 16 + fr) * LD + sblk + a * 16 + 4 * fq) = w; }
        if (tid < 128) { const float den = iwA[tid] * qnA[tid] + ((denp[tid] + denp[128 + tid]) + (denp[256 + tid] + denp[384 + tid])); dinvA[tid] = 1.0f / fmaxf(fabsf(den), emA[tid]); }
        __syncthreads();
#pragma unroll
        for (int a = 0; a < 2; ++a) { const f32x4 iw = *(const LAS f32x4*)(iwA + tb + a * 16 + 4 * fq);
#pragma unroll
            for (int b = 0; b < 2; ++b) nacc[a][b] *= iw; }
        const float decay = scal[0];
#pragma unroll
        for (int a = 0; a < 2; ++a)
#pragma unroll
            for (int b = 0; b < 2; ++b) cacc[a][b] *= decay;
#pragma unroll 1
        for (int kk = 0; kk < 4; ++kk) { const int ko = kk * 32 + fq * 8;
            bf16x8 pa[2], vb[2], kta[2];
#pragma unroll
            for (int a = 0; a < 2; ++a) { pa[a] = *(const LAS bf16x8*)(sK + (tb + a * 16 + fr) * LD + ko); vb[a] = *(const LAS bf16x8*)(sVt + (eb + a * 16 + fr) * LD + ko); kta[a] = *(const LAS bf16x8*)(sKt + (tb + a * 16 + fr) * LD + ko); }
#pragma unroll
            for (int a = 0; a < 2; ++a)
#pragma unroll
                for (int b = 0; b < 2; ++b) { nacc[a][b] = MFMA16(pa[a], vb[b], nacc[a][b]); cacc[a][b] = MFMA16(kta[a], vb[b], cacc[a][b]); } }
        float nsum;
        { const int d = tid >> 2, part = tid & 3; float s = 0.f;
#pragma unroll
          for (int k = 0; k < 4; ++k) { const u32x4 kv = *(const LAS u32x4*)(sKt + d * LD + part * 32 + k * 8);
              s += (bflo(kv.x) + bfhi(kv.x)) + (bflo(kv.y) + bfhi(kv.y)) + (bflo(kv.z) + bfhi(kv.z)) + (bflo(kv.w) + bfhi(kv.w)); }
          s += __shfl_xor(s, 1); s += __shfl_xor(s, 2); nsum = s; }
#pragma unroll
        for (int a = 0; a < 2; ++a) { const f32x4 di = *(const LAS f32x4*)(dinvA + tb + a * 16 + 4 * fq);
#pragma unroll
            for (int r = 0; r < 4; ++r) { const int t = tb + a * 16 + 4 * fq + r; const size_t tok = (size_t)(base + (dir ? 127 - t : t));
#pragma unroll
                for (int b = 0; b < 2; ++b) { const float hv = nacc[a][b][r] * di[r]; Hg[tok * 1024 + eb + b * 16 + fr] = (bf16_t)(cvt_pk_bf16(hv, hv) & 0xffffu); } } }
        __syncthreads();
#pragma unroll
        for (int a = 0; a < 2; ++a)
#pragma unroll
            for (int b = 0; b < 2; ++b) { u32x2 w; w.x = cvt_pk_bf16(cacc[a][b][0], cacc[a][b][1]); w.y = cvt_pk_bf16(cacc[a][b][2], cacc[a][b][3]);
                *(LAS u32x2*)(sCt + (eb + b * 16 + fr) * LD + tb + a * 16 + 4 * fq) = w; }
        if ((tid & 3) == 0) nvA[tid >> 2] = decay * nvA[tid >> 2] + nsum;
    }
    __syncthreads();
#undef SC_PREFETCH
}
}

namespace dattn {
constexpr int KVBLK = 64;
constexpr float SCALE = 0.125f;
constexpr float THR = 8.f;
constexpr int LDQ = 128, LDK = 128;
constexpr size_t SHM_V = KVBLK * 128 * 2, SHM_K = KVBLK * 128 * 2;
constexpr int O_WS = 2 * SHM_V + 2 * SHM_K;
constexpr int O_LUT = O_WS + 8 * 64 * 4;
#define KSWZ(row, colB) ((row) * 256 + ((colB) ^ (((row) & 7) << 4)))
#define SBAR() __builtin_amdgcn_sched_barrier(0)
DI int crow(int r, int hi) { return (r & 3) + 8 * (r >> 2) + 4 * hi; }
DI unsigned cvtpk(float lo, float hi) { unsigned r; asm volatile("v_cvt_pk_bf16_f32 %0, %1, %2" : "=v"(r) : "v"(lo), "v"(hi)); return r; }

DI void partialSM(f32x16& p0, f32x16& p1, float& m_reg, float& mn, float& alpha, float cadd) {
    constexpr float C = SCALE * 1.4426950408889634f;
    float pmax = p0[0];
#pragma unroll
    for (int r = 1; r < 16; ++r) pmax = fmaxf(pmax, p0[r]);
#pragma unroll
    for (int r = 0; r < 16; ++r) pmax = fmaxf(pmax, p1[r]);
    { auto rr = __builtin_amdgcn_permlane32_swap(__float_as_uint(pmax), __float_as_uint(pmax), false, false);
      pmax = fmaxf(__uint_as_float(rr[0]), __uint_as_float(rr[1])) + cadd; }
    if (__builtin_expect(__all(pmax - m_reg <= THR / SCALE), 1)) { mn = m_reg; alpha = 1.f; }
    else { mn = fmaxf(m_reg, pmax); alpha = __builtin_amdgcn_exp2f((m_reg - mn) * C); m_reg = mn; }
    const float mnC = (cadd - mn) * C;
#pragma unroll
    for (int r = 0; r < 16; ++r) p0[r] = fmaf(p0[r], C, mnC);
#pragma unroll
    for (int r = 0; r < 16; ++r) p1[r] = fmaf(p1[r], C, mnC);
#pragma unroll
    for (int r = 0; r < 16; ++r) p0[r] = __builtin_amdgcn_exp2f(p0[r]);
}
constexpr float THRL = 11.5415603f;
DI void partialSM4(f32x16& p0, f32x16& p1, float& m_reg, float& alpha, bool first) {
    float pmax = p0[0];
#pragma unroll
    for (int r = 1; r < 16; ++r) pmax = fmaxf(pmax, p0[r]);
#pragma unroll
    for (int r = 0; r < 16; ++r) pmax = fmaxf(pmax, p1[r]);
    { auto rr = __builtin_amdgcn_permlane32_swap(__float_as_uint(pmax), __float_as_uint(pmax), false, false);
      pmax = fmaxf(__uint_as_float(rr[0]), __uint_as_float(rr[1])); }
    const float delta = first ? pmax : (pmax <= THRL ? 0.f : pmax);
    alpha = 1.f;
    if (__builtin_expect(!__all(delta == 0.f), 0)) {
        if (!first) alpha = __builtin_amdgcn_exp2f(-delta);
        m_reg += delta;
#pragma unroll
        for (int r = 0; r < 16; ++r) { p0[r] -= delta; p1[r] -= delta; }
    }
#pragma unroll
    for (int r = 0; r < 16; ++r) p0[r] = __builtin_amdgcn_exp2f(p0[r]);
}
DI void finishSM(f32x16& p0, f32x16& p1, float alpha, float& l_reg, bf16x8& pa0, bf16x8& pa1, bf16x8& pa2, bf16x8& pa3) {
#pragma unroll
    for (int r = 0; r < 16; ++r) p1[r] = __builtin_amdgcn_exp2f(p1[r]);
    float ps = 0;
#pragma unroll
    for (int r = 0; r < 16; ++r) ps += p0[r];
#pragma unroll
    for (int r = 0; r < 16; ++r) ps += p1[r];
    { auto rr = __builtin_amdgcn_permlane32_swap(__float_as_uint(ps), __float_as_uint(ps), false, false);
      ps = __uint_as_float(rr[0]) + __uint_as_float(rr[1]); }
    l_reg = l_reg * alpha + ps;
#define PK4(P, BASE, OUT) do { unsigned a0 = cvtpk(P[BASE + 0], P[BASE + 1]), a1 = cvtpk(P[BASE + 2], P[BASE + 3]);   \
    unsigned b0 = cvtpk(P[BASE + 4], P[BASE + 5]), b1 = cvtpk(P[BASE + 6], P[BASE + 7]);                              \
    auto r0 = __builtin_amdgcn_permlane32_swap(a0, b0, false, false); auto r1 = __builtin_amdgcn_permlane32_swap(a1, b1, false, false); \
    u32x4 w = {r0[0], r1[0], r0[1], r1[1]}; OUT = *reinterpret_cast<bf16x8*>(&w); } while (0)
    PK4(p0, 0, pa0); PK4(p0, 8, pa1); PK4(p1, 0, pa2); PK4(p1, 8, pa3);
#undef PK4
}
DI void qkt(f32x16& p0, f32x16& p1, const char* Ks, const bf16x8* qr, int r32, int hi, int map, const f32x16& cinit = f32x16{}) {
    p0 = cinit; p1 = cinit;
#pragma unroll
    for (int d0 = 0; d0 < 4; ++d0) { const int cb = ((map * 4 + d0) * 16 + hi * 8) * 2;
        const bf16x8 b0 = *reinterpret_cast<const bf16x8*>(Ks + KSWZ(r32, cb));
        const bf16x8 b1 = *reinterpret_cast<const bf16x8*>(Ks + KSWZ(32 + r32, cb));
        p0 = __builtin_amdgcn_mfma_f32_32x32x16_bf16(b0, qr[d0], p0, 0, 0, 0);
        p1 = __builtin_amdgcn_mfma_f32_32x32x16_bf16(b1, qr[d0], p1, 0, 0, 0); }
}
DI void add_bias_near(f32x16& p0, f32x16& p1, int kq, const float* lut) {
    asm volatile("" : "+v"(kq));
#pragma unroll
    for (int r = 0; r < 16; ++r) { const int k0 = kq + (r & 3) + 8 * (r >> 2); const int i0 = k0 < -128 ? -128 : (k0 > 128 ? 128 : k0); const int k1 = k0 + 32; const int i1 = k1 < -128 ? -128 : (k1 > 128 ? 128 : k1);
        p0[r] += lut[i0 + 128]; p1[r] += lut[i1 + 128]; }
}
DI int v_st(int k, int c) { const int kk = (k & ~0xC) | ((k & 4) << 1) | ((k & 8) >> 1); return ((kk >> 3) * 4 + (c >> 5)) * 512 + ((kk & 7) * 32 + (c & 31)) * 2; }
DI int v_rd_base(int lane) { return ((lane & 3) << 3) | (((lane >> 2) & 3) << 6) | (((lane >> 4) & 1) << 5) | (((lane >> 5) & 1) << 8); }
constexpr int v_rd_off(int d0, int ks, int half) { return d0 * 512 + ks * 4096 + half * 2048; }
template <int OFF> DI s16x4 tr_read(int vb) { s16x4 r; asm volatile("ds_read_b64_tr_b16 %0, %1 offset:%2" : "=&v"(r) : "v"(vb), "i"(OFF) : "memory"); return r; }
template <int D0> DI void pv_one(f32x16& od, int vb, bf16x8 pa0, bf16x8 pa1, bf16x8 pa2, bf16x8 pa3) {
    const s16x4 l0 = tr_read<v_rd_off(D0, 0, 0)>(vb), h0 = tr_read<v_rd_off(D0, 0, 1)>(vb), l1 = tr_read<v_rd_off(D0, 1, 0)>(vb), h1 = tr_read<v_rd_off(D0, 1, 1)>(vb);
    const s16x4 l2 = tr_read<v_rd_off(D0, 2, 0)>(vb), h2 = tr_read<v_rd_off(D0, 2, 1)>(vb), l3 = tr_read<v_rd_off(D0, 3, 0)>(vb), h3 = tr_read<v_rd_off(D0, 3, 1)>(vb);
    asm volatile("s_waitcnt lgkmcnt(0)" ::: "memory"); SBAR();
#define PK(L, H) (bf16x8){L[0], L[1], L[2], L[3], H[0], H[1], H[2], H[3]}
    od = __builtin_amdgcn_mfma_f32_32x32x16_bf16(pa0, PK(l0, h0), od, 0, 0, 0);
    od = __builtin_amdgcn_mfma_f32_32x32x16_bf16(pa1, PK(l1, h1), od, 0, 0, 0);
    od = __builtin_amdgcn_mfma_f32_32x32x16_bf16(pa2, PK(l2, h2), od, 0, 0, 0);
    od = __builtin_amdgcn_mfma_f32_32x32x16_bf16(pa3, PK(l3, h3), od, 0, 0, 0);
#undef PK
}
DI void pv_d0(f32x16* o, int vb, bf16x8 pa0, bf16x8 pa1, bf16x8 pa2, bf16x8 pa3) {
    pv_one<0>(o[0], vb, pa0, pa1, pa2, pa3); pv_one<1>(o[1], vb, pa0, pa1, pa2, pa3); pv_one<2>(o[2], vb, pa0, pa1, pa2, pa3); pv_one<3>(o[3], vb, pa0, pa1, pa2, pa3);
}

DI int v_rd_base2(int lane) { return ((lane & 3) << 3) | (((lane >> 2) & 3) << 6) | (((lane >> 4) & 1) << 5) | (((lane >> 5) & 1) << 11); }
constexpr int v_rd_off2(int d0, int ks, int half) { return d0 * 512 + ks * 4096 + half * 256; }
DI void finishSM5(f32x16& p0, f32x16& p1, float alpha, float& l_reg, bf16x8& pa0, bf16x8& pa1, bf16x8& pa2, bf16x8& pa3) {
#pragma unroll
    for (int r = 0; r < 16; ++r) p1[r] = __builtin_amdgcn_exp2f(p1[r]);
    float ps = 0;
#pragma unroll
    for (int r = 0; r < 16; ++r) ps += p0[r];
#pragma unroll
    for (int r = 0; r < 16; ++r) ps += p1[r];
    { auto rr = __builtin_amdgcn_permlane32_swap(__float_as_uint(ps), __float_as_uint(ps), false, false);
      ps = __uint_as_float(rr[0]) + __uint_as_float(rr[1]); }
    l_reg = l_reg * alpha + ps;
#define PK8(P, BASE, OUT) do { u32x4 w = {cvtpk(P[BASE + 0], P[BASE + 1]), cvtpk(P[BASE + 2], P[BASE + 3]), cvtpk(P[BASE + 4], P[BASE + 5]), cvtpk(P[BASE + 6], P[BASE + 7])}; OUT = *reinterpret_cast<bf16x8*>(&w); } while (0)
    PK8(p0, 0, pa0); PK8(p0, 8, pa1); PK8(p1, 0, pa2); PK8(p1, 8, pa3);
#undef PK8
}
template <int D0> DI void pv_one2(f32x16& od, int vb, bf16x8 pa0, bf16x8 pa1, bf16x8 pa2, bf16x8 pa3) {
    const s16x4 l0 = tr_read<v_rd_off2(D0, 0, 0)>(vb), h0 = tr_read<v_rd_off2(D0, 0, 1)>(vb), l1 = tr_read<v_rd_off2(D0, 1, 0)>(vb), h1 = tr_read<v_rd_off2(D0, 1, 1)>(vb);
    const s16x4 l2 = tr_read<v_rd_off2(D0, 2, 0)>(vb), h2 = tr_read<v_rd_off2(D0, 2, 1)>(vb), l3 = tr_read<v_rd_off2(D0, 3, 0)>(vb), h3 = tr_read<v_rd_off2(D0, 3, 1)>(vb);
    asm volatile("s_waitcnt lgkmcnt(0)" ::: "memory"); SBAR();
#define PK(L, H) (bf16x8){L[0], L[1], L[2], L[3], H[0], H[1], H[2], H[3]}
    od = __builtin_amdgcn_mfma_f32_32x32x16_bf16(pa0, PK(l0, h0), od, 0, 0, 0);
    od = __builtin_amdgcn_mfma_f32_32x32x16_bf16(pa1, PK(l1, h1), od, 0, 0, 0);
    od = __builtin_amdgcn_mfma_f32_32x32x16_bf16(pa2, PK(l2, h2), od, 0, 0, 0);
    od = __builtin_amdgcn_mfma_f32_32x32x16_bf16(pa3, PK(l3, h3), od, 0, 0, 0);
#undef PK
}
DI void pv_d0_2(f32x16* o, int vb, bf16x8 pa0, bf16x8 pa1, bf16x8 pa2, bf16x8 pa3) {
    pv_one2<0>(o[0], vb, pa0, pa1, pa2, pa3); pv_one2<1>(o[1], vb, pa0, pa1, pa2, pa3); pv_one2<2>(o[2], vb, pa0, pa1, pa2, pa3); pv_one2<3>(o[3], vb, pa0, pa1, pa2, pa3);
}
DI void partialSM6(f32x16& p0, f32x16& p1, float& m_reg, float& alpha, bool first) {
    float pmax = p0[0];
#pragma unroll
    for (int r = 1; r < 16; ++r) pmax = fmaxf(pmax, p0[r]);
#pragma unroll
    for (int r = 0; r < 16; ++r) pmax = fmaxf(pmax, p1[r]);
    alpha = 1.f; asm volatile("" : "+v"(pmax));
    if (__builtin_expect(first || !__all(pmax <= THRL), 0)) {
        { auto rr = __builtin_amdgcn_permlane32_swap(__float_as_uint(pmax), __float_as_uint(pmax), false, false);
          pmax = fmaxf(__uint_as_float(rr[0]), __uint_as_float(rr[1])); }
        const float delta = first ? pmax : (pmax <= THRL ? 0.f : pmax);
        if (!first) alpha = __builtin_amdgcn_exp2f(-delta);
        m_reg += delta;
#pragma unroll
        for (int r = 0; r < 16; ++r) { p0[r] -= delta; p1[r] -= delta; }
    }
#pragma unroll
    for (int r = 0; r < 16; ++r) p0[r] = __builtin_amdgcn_exp2f(p0[r]);
}
DI void finishSM6(f32x16& p0, f32x16& p1, float alpha, float& l_reg, bf16x8& pa0, bf16x8& pa1, bf16x8& pa2, bf16x8& pa3) {
#pragma unroll
    for (int r = 0; r < 16; ++r) p1[r] = __builtin_amdgcn_exp2f(p1[r]);
    float ps = l_reg * alpha;
#pragma unroll
    for (int r = 0; r < 16; ++r) ps += p0[r];
#pragma unroll
    for (int r = 0; r < 16; ++r) ps += p1[r];
    asm volatile("" : "+v"(ps)); l_reg = ps;
#define PK8(P, BASE, OUT) do { u32x4 w = {cvtpk(P[BASE + 0], P[BASE + 1]), cvtpk(P[BASE + 2], P[BASE + 3]), cvtpk(P[BASE + 4], P[BASE + 5]), cvtpk(P[BASE + 6], P[BASE + 7])}; OUT = *reinterpret_cast<bf16x8*>(&w); } while (0)
    PK8(p0, 0, pa0); PK8(p0, 8, pa1); PK8(p1, 0, pa2); PK8(p1, 8, pa3);
#undef PK8
}
constexpr float EBIG = 2978.0f;
DI void softmax7(f32x16& p0, f32x16& p1, float& m_reg, float& l_reg, float& alpha, bool first, bf16x8& pa0, bf16x8& pa1, bf16x8& pa2, bf16x8& pa3) {
#pragma unroll
    for (int r = 0; r < 16; ++r) p0[r] = __builtin_amdgcn_exp2f(p0[r]);
#pragma unroll
    for (int r = 0; r < 16; ++r) p1[r] = __builtin_amdgcn_exp2f(p1[r]);
    float ps = 0.f;
#pragma unroll
    for (int r = 0; r < 16; ++r) ps += p0[r];
#pragma unroll
    for (int r = 0; r < 16; ++r) ps += p1[r];
    alpha = 1.f; asm volatile("" : "+v"(ps));
    if (__builtin_expect(first || !__all(ps <= EBIG), 0)) {
        float emax = p0[0];
#pragma unroll
        for (int r = 1; r < 16; ++r) emax = fmaxf(emax, p0[r]);
#pragma unroll
        for (int r = 0; r < 16; ++r) emax = fmaxf(emax, p1[r]);
        { auto rr = __builtin_amdgcn_permlane32_swap(__float_as_uint(emax), __float_as_uint(emax), false, false);
          emax = fmaxf(__uint_as_float(rr[0]), __uint_as_float(rr[1])); }
        const float delta = (first || emax > EBIG) ? __builtin_amdgcn_logf(emax) : 0.f;
        const float f = __builtin_amdgcn_exp2f(-delta);
        if (!first) alpha = f;
        m_reg += delta; ps *= f;
#pragma unroll
        for (int r = 0; r < 16; ++r) { p0[r] *= f; p1[r] *= f; }
    }
    l_reg = l_reg * alpha + ps;
#define PK8(P, BASE, OUT) do { u32x4 w = {cvtpk(P[BASE + 0], P[BASE + 1]), cvtpk(P[BASE + 2], P[BASE + 3]), cvtpk(P[BASE + 4], P[BASE + 5]), cvtpk(P[BASE + 6], P[BASE + 7])}; OUT = *reinterpret_cast<bf16x8*>(&w); } while (0)
    PK8(p0, 0, pa0); PK8(p0, 8, pa1); PK8(p1, 0, pa2); PK8(p1, 8, pa3);
#undef PK8
}
DI bool softmax8(f32x16& p0, f32x16& p1, float& m_reg, float& l_reg, float& alpha, bool& shifted, float frame_t, bf16x8& pa0, bf16x8& pa1, bf16x8& pa2, bf16x8& pa3) {
    if (__builtin_expect(shifted, 0)) {
#pragma unroll
        for (int r = 0; r < 16; ++r) { p0[r] -= m_reg; p1[r] -= m_reg; }
    }
#pragma unroll
    for (int r = 0; r < 16; ++r) p0[r] = __builtin_amdgcn_exp2f(p0[r]);
#pragma unroll
    for (int r = 0; r < 16; ++r) p1[r] = __builtin_amdgcn_exp2f(p1[r]);
    float ps = 0.f;
#pragma unroll
    for (int r = 0; r < 16; ++r) ps += p0[r];
#pragma unroll
    for (int r = 0; r < 16; ++r) ps += p1[r];
    alpha = frame_t; asm volatile("" : "+v"(ps));
    const bool slow = !__all(ps <= EBIG);
    if (__builtin_expect(slow, 0)) {
        float emax = p0[0];
#pragma unroll
        for (int r = 1; r < 16; ++r) emax = fmaxf(emax, p0[r]);
#pragma unroll
        for (int r = 0; r < 16; ++r) emax = fmaxf(emax, p1[r]);
        { auto rr = __builtin_amdgcn_permlane32_swap(__float_as_uint(emax), __float_as_uint(emax), false, false);
          emax = fmaxf(__uint_as_float(rr[0]), __uint_as_float(rr[1])); }
        const float delta = emax > EBIG ? __builtin_amdgcn_logf(emax) : 0.f;
        const float f = __builtin_amdgcn_exp2f(-delta);
        alpha *= f; m_reg += delta; ps *= f; shifted = true;
#pragma unroll
        for (int r = 0; r < 16; ++r) { p0[r] *= f; p1[r] *= f; }
    }
    l_reg = l_reg * alpha + ps;
#define PK8(P, BASE, OUT) do { u32x4 w = {cvtpk(P[BASE + 0], P[BASE + 1]), cvtpk(P[BASE + 2], P[BASE + 3]), cvtpk(P[BASE + 4], P[BASE + 5]), cvtpk(P[BASE + 6], P[BASE + 7])}; OUT = *reinterpret_cast<bf16x8*>(&w); } while (0)
    PK8(p0, 0, pa0); PK8(p0, 8, pa1); PK8(p1, 0, pa2); PK8(p1, 8, pa3);
#undef PK8
    return slow;
}
#define TRK(KS, R) do { R##0 = tr_read<v_rd_off2(0, KS, 0)>(vb); R##1 = tr_read<v_rd_off2(0, KS, 1)>(vb); R##2 = tr_read<v_rd_off2(1, KS, 0)>(vb); R##3 = tr_read<v_rd_off2(1, KS, 1)>(vb); \
    R##4 = tr_read<v_rd_off2(2, KS, 0)>(vb); R##5 = tr_read<v_rd_off2(2, KS, 1)>(vb); R##6 = tr_read<v_rd_off2(3, KS, 0)>(vb); R##7 = tr_read<v_rd_off2(3, KS, 1)>(vb); } while (0)
#define PKV(L, H) (bf16x8){L[0], L[1], L[2], L[3], H[0], H[1], H[2], H[3]}
#define PVK(PA, R) do { o[0] = __builtin_amdgcn_mfma_f32_32x32x16_bf16(PA, PKV(R##0, R##1), o[0], 0, 0, 0); o[1] = __builtin_amdgcn_mfma_f32_32x32x16_bf16(PA, PKV(R##2, R##3), o[1], 0, 0, 0); \
    o[2] = __builtin_amdgcn_mfma_f32_32x32x16_bf16(PA, PKV(R##4, R##5), o[2], 0, 0, 0); o[3] = __builtin_amdgcn_mfma_f32_32x32x16_bf16(PA, PKV(R##6, R##7), o[3], 0, 0, 0); } while (0)
DI void mseg_pv(f32x16& p0, f32x16& p1, f32x16* o, const char* Ks, int vb, const bf16x8* qr, int r32, int hi, int map, bf16x8 pa0, bf16x8 pa1, bf16x8 pa2, bf16x8 pa3, const f32x16& cinit = f32x16{}) {
    s16x4 a0, a1, a2, a3, a4, a5, a6, a7, b0, b1, b2, b3, b4, b5, b6, b7;
    TRK(0, a);
    { bf16x8 kf[8];
#pragma unroll
      for (int d0 = 0; d0 < 4; ++d0) { const int cb = ((map * 4 + d0) * 16 + hi * 8) * 2; const int ka = (int)(uintptr_t)Ks + KSWZ(r32, cb);
          asm volatile("ds_read_b128 %0, %1" : "=&v"(kf[2 * d0]) : "v"(ka) : "memory");
          asm volatile("ds_read_b128 %0, %1 offset:8192" : "=&v"(kf[2 * d0 + 1]) : "v"(ka) : "memory"); }
      asm volatile("s_waitcnt lgkmcnt(0)" ::: "memory"); SBAR();
      p0 = cinit; p1 = cinit;
#pragma unroll
      for (int d0 = 0; d0 < 4; ++d0) { p0 = __builtin_amdgcn_mfma_f32_32x32x16_bf16(kf[2 * d0], qr[d0], p0, 0, 0, 0); p1 = __builtin_amdgcn_mfma_f32_32x32x16_bf16(kf[2 * d0 + 1], qr[d0], p1, 0, 0, 0); }
    }
    SBAR();
    TRK(1, b); SBAR();
    PVK(pa0, a); SBAR();
    TRK(2, a); asm volatile("s_waitcnt lgkmcnt(8)" ::: "memory"); SBAR();
    PVK(pa1, b); SBAR();
    TRK(3, b); asm volatile("s_waitcnt lgkmcnt(8)" ::: "memory"); SBAR();
    PVK(pa2, a); SBAR();
    asm volatile("s_waitcnt lgkmcnt(0)" ::: "memory"); SBAR();
    PVK(pa3, b);
}
#undef TRK
#undef PKV
#undef PVK
__device__ __forceinline__ void body(const bf16_t* __restrict__ Qs, const bf16_t* __restrict__ Kh, const bf16_t* __restrict__ Vh, bf16_t* __restrict__ Os,
                                     int seq, int qblk0, int head, float lam, const float* __restrict__ relb, const float* __restrict__ subg, char* lds) {
    int tid = threadIdx.x; asm volatile("" : "+v"(tid));
    const int wid = __builtin_amdgcn_readfirstlane(tid >> 6), lane = tid & 63, r32 = lane & 31, hi = lane >> 5, map = wid >> 2, wq = wid & 3;
    char* V_lds = lds; char* K_lds = lds + 2 * SHM_V;
    float* wsf = (float*)(lds + O_WS) + wid * 64; float* li_l = wsf; float* al_l = wsf + 32;
    float* lut = (float*)(lds + O_LUT);
    __syncthreads();
    if (tid < 257) lut[tid] = relb[rel_bucket(tid - 128) * 8 + head] * (1.0f / SCALE);
    const float cL = relb[15 * 8 + head] * (1.0f / SCALE), cR = relb[31 * 8 + head] * (1.0f / SCALE);
    float m_reg = -1e30f, l_reg = 0; f32x16 o[4] = {}; bf16x8 qr[4];
    const int qpos = qblk0 + wq * 32 + r32;
    const bf16_t* Qw = Qs + (size_t)qpos * LDQ + map * 64 + hi * 8;
#pragma unroll
    for (int d0 = 0; d0 < 4; ++d0) qr[d0] = *reinterpret_cast<const bf16x8*>(Qw + d0 * 16);
    const int sr = tid >> 4, sc = (tid & 15) * 8, vst0 = v_st(sr, sc), vst1 = v_st(32 + sr, sc);
    const int vb0 = (int)(uintptr_t)V_lds + v_rd_base(lane);
    struct { bf16x8 vs0, vs1, ks0, ks1; } sr_[2];
#define SLOAD(i, k0) do { sr_[i].vs0 = *(const bf16x8*)(&Vh[(size_t)((k0) + sr) * LDK + sc]); sr_[i].vs1 = *(const bf16x8*)(&Vh[(size_t)((k0) + 32 + sr) * LDK + sc]); \
    sr_[i].ks0 = *(const bf16x8*)(&Kh[(size_t)((k0) + sr) * LDK + sc]); sr_[i].ks1 = *(const bf16x8*)(&Kh[(size_t)((k0) + 32 + sr) * LDK + sc]); } while (0)
#define SWRITE(b, i) do { *(bf16x8*)(V_lds + (b) * SHM_V + vst0) = sr_[i].vs0;          \
    *(bf16x8*)(V_lds + (b) * SHM_V + vst1) = sr_[i].vs1; const int kc = sc * 2;               \
    *(bf16x8*)(K_lds + (b) * SHM_K + KSWZ(sr, kc)) = sr_[i].ks0;                       \
    *(bf16x8*)(K_lds + (b) * SHM_K + KSWZ(32 + sr, kc)) = sr_[i].ks1; } while (0)
#define SWAIT() asm volatile("s_waitcnt vmcnt(4)" ::: "memory")
#define RESC(a) do { if (__any((a) < 1.f)) { if (hi == 0) al_l[r32] = (a); asm volatile("s_waitcnt lgkmcnt(0)" ::: "memory"); \
    _Pragma("unroll") for (int d = 0; d < 4; ++d) _Pragma("unroll") for (int r = 0; r < 16; ++r) o[d][r] *= al_l[crow(r, hi)]; } } while (0)
#define QKT(P0, P1, buf, j) qkt(P0, P1, K_lds + (buf) * SHM_K, qr, r32, hi, map)
#define PSM(P0, P1, MN, AL, j) do { const int kb_ = (j) * KVBLK; float cadd_ = 0.f; \
    if (kb_ + 63 - qblk0 <= -91) cadd_ = cL; else if (kb_ - (qblk0 + 127) >= 91) cadd_ = cR; else add_bias_near(P0, P1, kb_ - qpos + 4 * hi, lut); \
    partialSM(P0, P1, m_reg, MN, AL, cadd_); } while (0)
    f32x16 pA0, pA1, pB0, pB1; float mnA, mnB, alA, alB; bf16x8 pa0, pa1, pa2, pa3; const int NT = seq / KVBLK;
    constexpr int SE = 0, SO = 1;
    SLOAD(SE, 0); asm volatile("s_waitcnt vmcnt(0)" ::: "memory"); SWRITE(0, SE); __syncthreads();
    QKT(pA0, pA1, 0, 0); PSM(pA0, pA1, mnA, alA, 0);
    SLOAD(SO, KVBLK); if (2 < NT) SLOAD(SE, 2 * KVBLK);
    SWAIT(); SWRITE(1, SO); __syncthreads();
    for (int j = 1; j + 1 < NT; j += 2) {
        SBAR(); QKT(pB0, pB1, 1, j);
        finishSM(pA0, pA1, alA, l_reg, pa0, pa1, pa2, pa3); SBAR();
        SLOAD(SO, (j + 2) * KVBLK); SBAR();
        pv_d0(o, vb0, pa0, pa1, pa2, pa3); PSM(pB0, pB1, mnB, alB, j);
        __syncthreads(); SWAIT(); SWRITE(0, SE);
        RESC(alB); __syncthreads();
        SBAR(); QKT(pA0, pA1, 0, j + 1);
        finishSM(pB0, pB1, alB, l_reg, pa0, pa1, pa2, pa3); SBAR();
        if (j + 3 < NT) SLOAD(SE, (j + 3) * KVBLK); SBAR();
        pv_d0(o, vb0 + (int)SHM_V, pa0, pa1, pa2, pa3); PSM(pA0, pA1, mnA, alA, j + 1);
        __syncthreads(); SWAIT(); SWRITE(1, SO);
        RESC(alA); __syncthreads();
    }
    SBAR(); QKT(pB0, pB1, 1, NT - 1);
    finishSM(pA0, pA1, alA, l_reg, pa0, pa1, pa2, pa3); SBAR();
    pv_d0(o, vb0, pa0, pa1, pa2, pa3); PSM(pB0, pB1, mnB, alB, NT - 1);
    __syncthreads(); RESC(alB);
    finishSM(pB0, pB1, alB, l_reg, pa0, pa1, pa2, pa3); SBAR();
    pv_d0(o, vb0 + (int)SHM_V, pa0, pa1, pa2, pa3);
    if (hi == 0) li_l[r32] = l_reg; asm volatile("s_waitcnt lgkmcnt(0)" ::: "memory");
    float rli[16];
#pragma unroll
    for (int r = 0; r < 16; ++r) rli[r] = __builtin_amdgcn_rcpf(li_l[crow(r, hi)]) * (map ? -lam : 1.0f);
    __syncthreads();
    float* X = (float*)lds;
    if (map == 1) {
#pragma unroll
        for (int r = 0; r < 16; ++r) { const int row = wq * 32 + crow(r, hi);
#pragma unroll
            for (int d0 = 0; d0 < 4; ++d0) X[row * 128 + d0 * 32 + r32] = o[d0][r] * rli[r]; }
    }
    __syncthreads();
    if (map == 0) {
#pragma unroll
        for (int r = 0; r < 16; ++r) { const int row = wq * 32 + crow(r, hi);
#pragma unroll
            for (int d0 = 0; d0 < 4; ++d0) X[row * 128 + d0 * 32 + r32] += o[d0][r] * rli[r]; }
    }
    __syncthreads();
    { const int row = tid >> 2, part = tid & 3; float v[32]; float s = 0.f;
#pragma unroll
      for (int k = 0; k < 8; ++k) { const f32x4 x = *(const f32x4*)(X + row * 128 + part * 32 + k * 4); v[4 * k] = x[0]; v[4 * k + 1] = x[1]; v[4 * k + 2] = x[2]; v[4 * k + 3] = x[3]; s += x[0] * x[0] + x[1] * x[1] + x[2] * x[2] + x[3] * x[3]; }
      s += __shfl_xor(s, 1); s += __shfl_xor(s, 2);
      const float rs = rsqrtf(s * (1.0f / 128.0f) + EPS) * (1.0f - LAMBDA_INIT1);
      bf16_t* op = Os + (size_t)(qblk0 + row) * 1024 + part * 32;
#pragma unroll
      for (int k = 0; k < 4; ++k) { const f32x4 g0 = *(const f32x4*)(subg + part * 32 + k * 8), g1 = *(const f32x4*)(subg + part * 32 + k * 8 + 4);
          pg8::st_bf16x8(op + k * 8, (f32x4){v[8 * k] * rs * g0[0], v[8 * k + 1] * rs * g0[1], v[8 * k + 2] * rs * g0[2], v[8 * k + 3] * rs * g0[3]},
                         (f32x4){v[8 * k + 4] * rs * g1[0], v[8 * k + 5] * rs * g1[1], v[8 * k + 6] * rs * g1[2], v[8 * k + 7] * rs * g1[3]}); } }
#undef SLOAD
#undef SWRITE
#undef SWAIT
#undef RESC
#undef QKT
#undef PSM
}
__device__ __forceinline__ void body2(const bf16_t* __restrict__ Qs, const bf16_t* __restrict__ Kh, const bf16_t* __restrict__ Vh, bf16_t* __restrict__ Os,
                                     int seq, int qblk0, int head, float lam, const float* __restrict__ relb, const float* __restrict__ subg, char* lds) {
    int tid = threadIdx.x; asm volatile("" : "+v"(tid));
    const int wid = __builtin_amdgcn_readfirstlane(tid >> 6), lane = tid & 63, r32 = lane & 31, hi = lane >> 5, map = wid >> 2, wq = wid & 3;
    char* V_lds = lds; char* K_lds = lds + 2 * SHM_V;
    float* wsf = (float*)(lds + O_WS) + wid * 64; float* li_l = wsf; float* al_l = wsf + 32;
    float* lut = (float*)(lds + O_LUT);
    __syncthreads();
    if (tid < 257) lut[tid] = relb[rel_bucket(tid - 128) * 8 + head] * (1.0f / SCALE);
    const float cL = relb[15 * 8 + head] * (1.0f / SCALE), cR = relb[31 * 8 + head] * (1.0f / SCALE);
    float m_reg = -1e30f, l_reg = 0; f32x16 o[4] = {}; bf16x8 qr[4];
    const int qpos = qblk0 + wq * 32 + r32;
    const bf16_t* Qw = Qs + (size_t)qpos * LDQ + map * 64 + hi * 8;
#pragma unroll
    for (int d0 = 0; d0 < 4; ++d0) qr[d0] = *reinterpret_cast<const bf16x8*>(Qw + d0 * 16);
    const int sr = tid >> 4, sc = (tid & 15) * 8, vst0 = v_st(sr, sc), vst1 = v_st(32 + sr, sc);
    const int vb0 = (int)(uintptr_t)V_lds + v_rd_base(lane);
    bf16x8 ks0, ks1, vs0, vs1;
    const unsigned toff = (unsigned)(sr * LDK + sc) * 2u;
#define KLOAD(k0) do { const char* kb_ = (const char*)Kh + (size_t)(k0) * (LDK * 2); ks0 = *(const bf16x8*)(kb_ + toff); ks1 = *(const bf16x8*)(kb_ + 32 * LDK * 2 + toff); } while (0)
#define VLOAD(k0) do { const char* vb_ = (const char*)Vh + (size_t)(k0) * (LDK * 2); vs0 = *(const bf16x8*)(vb_ + toff); vs1 = *(const bf16x8*)(vb_ + 32 * LDK * 2 + toff); } while (0)
#define KWRITE(b) do { const int kc = sc * 2; *(bf16x8*)(K_lds + (b) * SHM_K + KSWZ(sr, kc)) = ks0; *(bf16x8*)(K_lds + (b) * SHM_K + KSWZ(32 + sr, kc)) = ks1; } while (0)
#define VWRITE(b) do { *(bf16x8*)(V_lds + (b) * SHM_V + vst0) = vs0; *(bf16x8*)(V_lds + (b) * SHM_V + vst1) = vs1; } while (0)
#define RESC(a) do { if (__any((a) < 1.f)) { if (hi == 0) al_l[r32] = (a); asm volatile("s_waitcnt lgkmcnt(0)" ::: "memory"); \
    _Pragma("unroll") for (int d = 0; d < 4; ++d) _Pragma("unroll") for (int r = 0; r < 16; ++r) o[d][r] *= al_l[crow(r, hi)]; } } while (0)
#define PSM(P0, P1, MN, AL, j) do { const int kb_ = (j) * KVBLK; float cadd_ = 0.f; \
    if (kb_ + 63 - qblk0 <= -91) cadd_ = cL; else if (kb_ - (qblk0 + 127) >= 91) cadd_ = cR; else add_bias_near(P0, P1, kb_ - qpos + 4 * hi, lut); \
    partialSM(P0, P1, m_reg, MN, AL, cadd_); } while (0)
#define MSEG(j) do { qkt(p0, p1, K_lds + ((j) & 1) * SHM_K, qr, r32, hi, map); if ((j) > 0) pv_d0(o, vb0 + (((j) - 1) & 1) * (int)SHM_V, pa0, pa1, pa2, pa3); } while (0)
#ifdef X_NORESC
#define VSEG(j) do { PSM(p0, p1, mn, al, (j)); finishSM(p0, p1, al, l_reg, pa0, pa1, pa2, pa3); } while (0)
#else
#define VSEG(j) do { PSM(p0, p1, mn, al, (j)); RESC(al); finishSM(p0, p1, al, l_reg, pa0, pa1, pa2, pa3); } while (0)
#endif
    f32x16 p0, p1; float mn, al; bf16x8 pa0, pa1, pa2, pa3; const int NT = seq / KVBLK;
    KLOAD(0); KWRITE(0);
#define STAGE(j) do { if ((j) + 1 < NT) KWRITE(((j) + 1) & 1); VWRITE((j) & 1); if ((j) + 2 < NT) KLOAD(((j) + 2) * KVBLK); if ((j) + 1 < NT) VLOAD(((j) + 1) * KVBLK); SBAR(); } while (0)
    KLOAD(KVBLK); VLOAD(0);
    __syncthreads();
    if (map == 0) {
        qkt(p0, p1, K_lds, qr, r32, hi, 0);
        STAGE(0); VSEG(0); __syncthreads();
        for (int j = 1; j < NT; ++j) {
            mseg_pv(p0, p1, o, K_lds + (j & 1) * SHM_K, vb0 + ((j - 1) & 1) * (int)SHM_V, qr, r32, hi, 0, pa0, pa1, pa2, pa3);
            STAGE(j); VSEG(j);
            __syncthreads();
        }
        pv_d0(o, vb0 + ((NT - 1) & 1) * (int)SHM_V, pa0, pa1, pa2, pa3);
    } else {
        STAGE(0); qkt(p0, p1, K_lds, qr, r32, hi, 1); __syncthreads();
        for (int j = 1; j < NT; ++j) {
            VSEG(j - 1);
            STAGE(j);
            mseg_pv(p0, p1, o, K_lds + (j & 1) * SHM_K, vb0 + ((j - 1) & 1) * (int)SHM_V, qr, r32, hi, 1, pa0, pa1, pa2, pa3);
            __syncthreads();
        }
        VSEG(NT - 1);
        pv_d0(o, vb0 + ((NT - 1) & 1) * (int)SHM_V, pa0, pa1, pa2, pa3);
    }
#undef STAGE
    if (hi == 0) li_l[r32] = l_reg; asm volatile("s_waitcnt lgkmcnt(0)" ::: "memory");
    float rli[16];
#pragma unroll
    for (int r = 0; r < 16; ++r) rli[r] = __builtin_amdgcn_rcpf(li_l[crow(r, hi)]) * (map ? -lam : 1.0f);
    __syncthreads();
    float* X = (float*)lds;
    if (map == 1) {
#pragma unroll
        for (int r = 0; r < 16; ++r) { const int row = wq * 32 + crow(r, hi);
#pragma unroll
            for (int d0 = 0; d0 < 4; ++d0) X[row * 128 + d0 * 32 + r32] = o[d0][r] * rli[r]; }
    }
    __syncthreads();
    if (map == 0) {
#pragma unroll
        for (int r = 0; r < 16; ++r) { const int row = wq * 32 + crow(r, hi);
#pragma unroll
            for (int d0 = 0; d0 < 4; ++d0) X[row * 128 + d0 * 32 + r32] += o[d0][r] * rli[r]; }
    }
    __syncthreads();
    { const int row = tid >> 2, part = tid & 3; float v[32]; float s = 0.f;
#pragma unroll
      for (int k = 0; k < 8; ++k) { const f32x4 x = *(const f32x4*)(X + row * 128 + part * 32 + k * 4); v[4 * k] = x[0]; v[4 * k + 1] = x[1]; v[4 * k + 2] = x[2]; v[4 * k + 3] = x[3]; s += x[0] * x[0] + x[1] * x[1] + x[2] * x[2] + x[3] * x[3]; }
      s += __shfl_xor(s, 1); s += __shfl_xor(s, 2);
      const float rs = rsqrtf(s * (1.0f / 128.0f) + EPS) * (1.0f - LAMBDA_INIT1);
      bf16_t* op = Os + (size_t)(qblk0 + row) * 1024 + part * 32;
#pragma unroll
      for (int k = 0; k < 4; ++k) { const f32x4 g0 = *(const f32x4*)(subg + part * 32 + k * 8), g1 = *(const f32x4*)(subg + part * 32 + k * 8 + 4);
          pg8::st_bf16x8(op + k * 8, (f32x4){v[8 * k] * rs * g0[0], v[8 * k + 1] * rs * g0[1], v[8 * k + 2] * rs * g0[2], v[8 * k + 3] * rs * g0[3]},
                         (f32x4){v[8 * k + 4] * rs * g1[0], v[8 * k + 5] * rs * g1[1], v[8 * k + 6] * rs * g1[2], v[8 * k + 7] * rs * g1[3]}); } }
#undef KLOAD
#undef VLOAD
#undef KWRITE
#undef VWRITE
#undef RESC
#undef PSM
#undef MSEG
#undef VSEG
}

constexpr int O_WS4 = 6 * 16384;
constexpr int O_LUT4 = O_WS4 + 8 * 64 * 4;
__device__ __forceinline__ void body4(const bf16_t* __restrict__ Qs, const bf16_t* __restrict__ Kh, const bf16_t* __restrict__ Vh, bf16_t* __restrict__ Os,
                                      int seq, int qblk0, int head, float lam, const float* __restrict__ relb, const float* __restrict__ subg, char* lds, LAS unsigned char* ldsl, int wv) {
    int tid = tid_of(wv); asm volatile("" : "+v"(tid));
    const int wid = wv, lane = tid & 63, r32 = lane & 31, hi = lane >> 5, map = wid >> 2, wq = wid & 3;
    char* V_lds = lds; char* K_lds = lds + 3 * SHM_V;
    LAS float* wsf = (LAS float*)(ldsl + O_WS4) + wid * 64; LAS float* li_l = wsf; LAS float* al_l = wsf + 32;
    LAS float* lutl = (LAS float*)(ldsl + O_LUT4); const float* lut = (const float*)(lds + O_LUT4);
    __syncthreads();
    if (tid < 257) lutl[tid] = relb[rel_bucket(tid - 128) * 8 + head] * 1.4426950408889634f;
    const float cL = relb[15 * 8 + head] * 1.4426950408889634f, cR = relb[31 * 8 + head] * 1.4426950408889634f;
    float m_reg = 0.f, l_reg = 0; f32x16 o[4] = {}; bf16x8 qr[4];
    const int qpos = qblk0 + wq * 32 + r32;
    const bf16_t* Qw = Qs + (size_t)qpos * LDQ + map * 64 + hi * 8;
#pragma unroll
    for (int d0 = 0; d0 < 4; ++d0) qr[d0] = *reinterpret_cast<const bf16x8*>(Qw + d0 * 16);
    const int vb0 = (int)(uintptr_t)V_lds + v_rd_base2(lane);
    unsigned gk0, gv0;
    { const int ch0 = wid;
      { const int row = ch0 * 4 + (lane >> 4), b = (lane & 15) * 16; gk0 = (unsigned)(row * 256 + (b ^ ((row & 7) << 4))); }
      { const int st = ch0 * 2 + (lane >> 5), kk = (st >> 2) * 8 + ((lane & 31) >> 2), k = (kk & ~0xC) | ((kk & 4) << 1) | ((kk & 8) >> 1), cc = (st & 3) * 32 + (lane & 3) * 8; gv0 = (unsigned)(k * 256 + cc * 2); }
    }
    LAS unsigned char* Vl = ldsl; LAS unsigned char* Kl = ldsl + 3 * SHM_V;
    const int NT = seq / KVBLK;
#define DMA_K(t, slot) do { const int t_ = (t) < NT ? (t) : NT - 1; const char* g_ = (const char*)Kh + (size_t)t_ * (KVBLK * 256); \
    __builtin_amdgcn_global_load_lds((const unsigned*)(g_ + gk0), (LAS unsigned*)(Kl + (slot) * 16384 + wid * 1024), 16, 0, 0); \
    __builtin_amdgcn_global_load_lds((const unsigned*)(g_ + 8192 + gk0), (LAS unsigned*)(Kl + (slot) * 16384 + 8192 + wid * 1024), 16, 0, 0); } while (0)
#define DMA_V(t, slot) do { const int t_ = (t) < NT ? (t) : NT - 1; const char* g_ = (const char*)Vh + (size_t)t_ * (KVBLK * 256); \
    __builtin_amdgcn_global_load_lds((const unsigned*)(g_ + gv0), (LAS unsigned*)(Vl + (slot) * 16384 + wid * 1024), 16, 0, 0); \
    __builtin_amdgcn_global_load_lds((const unsigned*)(g_ + 8192 + gv0), (LAS unsigned*)(Vl + (slot) * 16384 + 8192 + wid * 1024), 16, 0, 0); } while (0)
#define TBAR(n) do { asm volatile("s_waitcnt vmcnt(" #n ") lgkmcnt(0)" ::: "memory"); __builtin_amdgcn_s_barrier(); asm volatile("" ::: "memory"); } while (0)
#define RESC(a) do { if (__any((a) != 1.f)) { if (hi == 0) al_l[r32] = (a); asm volatile("s_waitcnt lgkmcnt(0)" ::: "memory"); \
    _Pragma("unroll") for (int d = 0; d < 4; ++d) _Pragma("unroll") for (int r = 0; r < 16; ++r) o[d][r] *= al_l[crow(r, hi)]; } } while (0)
#define TCLS(j) (((j) * KVBLK + 63 - qblk0 <= -91) ? 0 : (((j) * KVBLK - (qblk0 + 127) >= 91) ? 2 : 1))
#define TCV(c) ((c) == 0 ? cL : ((c) == 2 ? cR : 0.f))
#define VSEG(j) do { if (TCLS(j) == 1) add_bias_near(p0, p1, (j) * KVBLK - qpos + 4 * hi, lut); \
    float ft_ = 1.f; const bool fc_ = (j) > 0 && TCLS(j) != TCLS((j) - 1); if (fc_) ft_ = __builtin_amdgcn_exp2f(TCV(TCLS((j) - 1)) - TCV(TCLS(j))); \
    const bool sl_ = softmax8(p0, p1, m_reg, l_reg, al, shifted, ft_, pa0, pa1, pa2, pa3); \
    if (__builtin_expect(sl_ || fc_, 0)) { if (hi == 0) al_l[r32] = al; asm volatile("s_waitcnt lgkmcnt(0)" ::: "memory"); \
        _Pragma("unroll") for (int d = 0; d < 4; ++d) _Pragma("unroll") for (int r = 0; r < 16; ++r) o[d][r] *= al_l[crow(r, hi)]; } } while (0)
    f32x16 p0, p1; float al; bf16x8 pa0, pa1, pa2, pa3;
    bool shifted = false; const f32x16 cinit = f32x16{};
    DMA_K(0, 0); DMA_V(0, 0); DMA_K(1, 1);
    TBAR(0);
    int s0 = 0, s1 = 1, s2 = 2;
    if (map == 0) {
        DMA_K(2, s2); DMA_V(1, s1);
        qkt(p0, p1, K_lds + s0 * SHM_K, qr, r32, hi, 0, cinit);
        VSEG(0); TBAR(4);
        for (int j = 1; j < NT; ++j) {
            { const int t_ = s0; s0 = s1; s1 = s2; s2 = t_; }
            DMA_K(j + 2, s2); DMA_V(j + 1, s1);
            mseg_pv(p0, p1, o, K_lds + s0 * SHM_K, vb0 + s2 * (int)SHM_V, qr, r32, hi, 0, pa0, pa1, pa2, pa3, cinit);
            VSEG(j);
            TBAR(4);
        }
        pv_d0_2(o, vb0 + s0 * (int)SHM_V, pa0, pa1, pa2, pa3);
    } else {
        DMA_K(2, s2); DMA_V(1, s1);
        qkt(p0, p1, K_lds + s0 * SHM_K, qr, r32, hi, 1, cinit); TBAR(4);
        for (int j = 1; j < NT; ++j) {
            { const int t_ = s0; s0 = s1; s1 = s2; s2 = t_; }
            DMA_K(j + 2, s2); DMA_V(j + 1, s1);
            VSEG(j - 1);
            mseg_pv(p0, p1, o, K_lds + s0 * SHM_K, vb0 + s2 * (int)SHM_V, qr, r32, hi, 1, pa0, pa1, pa2, pa3, cinit);
            TBAR(4);
        }
        VSEG(NT - 1);
        pv_d0_2(o, vb0 + s0 * (int)SHM_V, pa0, pa1, pa2, pa3);
    }
    asm volatile("s_waitcnt vmcnt(0)" ::: "memory");
    li_l[lane] = l_reg; asm volatile("s_waitcnt lgkmcnt(0)" ::: "memory");
    { const float lr_ = li_l[r32] + li_l[32 + r32]; asm volatile("s_waitcnt lgkmcnt(0)" ::: "memory"); if (hi == 0) li_l[r32] = lr_; asm volatile("s_waitcnt lgkmcnt(0)" ::: "memory"); }
    float rli[16];
#pragma unroll
    for (int r = 0; r < 16; ++r) rli[r] = __builtin_amdgcn_rcpf(li_l[crow(r, hi)]) * (map ? -lam : 1.0f);
    __syncthreads();
    float* X = (float*)lds;
    if (map == 1) {
#pragma unroll
        for (int r = 0; r < 16; ++r) { const int row = wq * 32 + crow(r, hi);
#pragma unroll
            for (int d0 = 0; d0 < 4; ++d0) X[row * 128 + d0 * 32 + r32] = o[d0][r] * rli[r]; }
    }
    __syncthreads();
    if (map == 0) {
#pragma unroll
        for (int r = 0; r < 16; ++r) { const int row = wq * 32 + crow(r, hi);
#pragma unroll
            for (int d0 = 0; d0 < 4; ++d0) X[row * 128 + d0 * 32 + r32] += o[d0][r] * rli[r]; }
    }
    __syncthreads();
    { const int row = tid >> 2, part = tid & 3; float v[32]; float s2_ = 0.f;
#pragma unroll
      for (int k = 0; k < 8; ++k) { const f32x4 x = *(const f32x4*)(X + row * 128 + part * 32 + k * 4); v[4 * k] = x[0]; v[4 * k + 1] = x[1]; v[4 * k + 2] = x[2]; v[4 * k + 3] = x[3]; s2_ += x[0] * x[0] + x[1] * x[1] + x[2] * x[2] + x[3] * x[3]; }
      s2_ += __shfl_xor(s2_, 1); s2_ += __shfl_xor(s2_, 2);
      const float rs = rsqrtf(s2_ * (1.0f / 128.0f) + EPS) * (1.0f - LAMBDA_INIT1);
      bf16_t* op = Os + (size_t)(qblk0 + row) * 1024 + part * 32;
#pragma unroll
      for (int k = 0; k < 4; ++k) { const f32x4 g0 = *(const f32x4*)(subg + part * 32 + k * 8), g1 = *(const f32x4*)(subg + part * 32 + k * 8 + 4);
          pg8::st_bf16x8(op + k * 8, (f32x4){v[8 * k] * rs * g0[0], v[8 * k + 1] * rs * g0[1], v[8 * k + 2] * rs * g0[2], v[8 * k + 3] * rs * g0[3]},
                         (f32x4){v[8 * k + 4] * rs * g1[0], v[8 * k + 5] * rs * g1[1], v[8 * k + 6] * rs * g1[2], v[8 * k + 7] * rs * g1[3]}); } }
#undef DMA_K
#undef DMA_V
#undef TBAR
#undef RESC
#undef TCLS
#undef TCV
#undef VSEG
}
}

DI void grid_barrier(unsigned* ctr, unsigned& epoch, unsigned G, int wv) {
    asm volatile("s_waitcnt vmcnt(0)" ::: "memory");
    __syncthreads();
    if (wv == 0 && lane_id() == 0) {
        __builtin_amdgcn_fence(__ATOMIC_RELEASE, "agent");
        asm volatile("s_waitcnt vmcnt(0)" ::: "memory");
        __hip_atomic_fetch_add(ctr, 1u, __ATOMIC_RELAXED, __HIP_MEMORY_SCOPE_AGENT);
        const unsigned target = (epoch + 1u) * G;
        while (__hip_atomic_load(ctr, __ATOMIC_RELAXED, __HIP_MEMORY_SCOPE_AGENT) < target) __builtin_amdgcn_s_sleep(1);
        __builtin_amdgcn_fence(__ATOMIC_ACQUIRE, "agent");
        asm volatile("s_waitcnt vmcnt(0)" ::: "memory");
    }
    ++epoch;
    __syncthreads();
}

__global__ void __launch_bounds__(NTHREADS, 2) fwd_kernel(Params p) {
    extern __shared__ __attribute__((aligned(16))) unsigned char lds_raw[];
    LAS unsigned char* lds = (LAS unsigned char*)lds_raw;
    cg::grid_group grid = cg::this_grid();
    const int wv = __builtin_amdgcn_readfirstlane(threadIdx.x >> 6);
    const int G = gridDim.x, c = blockIdx.x;
#define tid tid_of(wv)
    unsigned char* ws = p.ws;
#ifdef PH_LO
    const int lo = PH_LO, hi = PH_HI;
#else
    const int lo = p.ph_lo, hi = p.ph_hi;
#endif
#define IN(k) (lo <= (k) && (k) < hi)
#define SEAM(k) do { if (IN(k) && IN((k) + 1)) { if ((k) == 0) grid.sync(); else grid_barrier(bar_ctr, bar_epoch, (unsigned)G, wv); } } while (0)
    unsigned* bar_ctr = (unsigned*)(ws + O_MISC + 16384); unsigned bar_epoch = 0;
    float* rowss = (float*)(ws + O_ROWSS);
    float* memss = (float*)(ws + O_MISC);
    float* lamp = (float*)(ws + O_MISC + 8192);
    const float* x_prompt = p.in[0]; const float* x_sample = p.in[1];
    bf16_t* R0 = (bf16_t*)(ws + O_R0); bf16_t* R1 = (bf16_t*)(ws + O_R1); bf16_t* R2 = (bf16_t*)(ws + O_R2);

    if (IN(0)) {
        LAS float* tl = (LAS float*)lds;
        for (int jb = 0; jb < 15; ++jb) {
            CvtJob J; J.sn0 = 0; J.sn1 = 0; J.sscale = 1.f; J.g = nullptr; J.K = 1024; J.ldd = 1024;
            const int l = (jb >= 7) ? (jb - 7) / 4 : 0, w = (jb >= 7) ? (jb - 7) % 4 : 0;
            switch (jb) {
            case 0: J.src = p.in[9]; J.lds_src = 3072; J.col0 = 0; J.N = 1024; J.nvalid = 1024; J.g = p.in[4]; J.dst = (bf16_t*)(ws + O_WA); J.sn0 = 512; J.sn1 = 1024; J.sscale = 0.08838834764831845f; break;
            case 1: J.src = p.in[10]; J.lds_src = 16; J.col0 = 0; J.N = 256; J.nvalid = 16; J.g = p.in[4]; J.dst = (bf16_t*)(ws + O_WA) + 1024 * 1024; break;
            case 2: J.src = p.in[9]; J.lds_src = 3072; J.col0 = 512; J.N = 1536; J.nvalid = 1536; J.g = p.in[4]; J.dst = (bf16_t*)(ws + O_WB); J.sn0 = 0; J.sn1 = 512; J.sscale = 0.08838834764831845f; break;
            case 3: J.src = p.in[9]; J.lds_src = 3072; J.col0 = 2048; J.N = 1024; J.nvalid = 1024; J.g = p.in[4]; J.dst = (bf16_t*)(ws + O_WO); break;
            case 4: J.src = p.in[13]; J.lds_src = 1024; J.col0 = 0; J.N = 1024; J.nvalid = 1024; J.dst = (bf16_t*)(ws + O_WAOUT); break;
            case 5: J.src = p.in[14]; J.lds_src = 3072; J.col0 = 0; J.N = 3072; J.nvalid = 3072; J.g = p.in[4] + 1024; J.dst = (bf16_t*)(ws + O_WQKV); J.sn0 = 0; J.sn1 = 1024; J.sscale = 0.18033688011112042f; break;
            case 6: J.src = p.in[17]; J.lds_src = 1024; J.col0 = 0; J.N = 1024; J.nvalid = 1024; J.dst = (bf16_t*)(ws + O_WBOUT); break;
            default:
                if (w == 0) { J.src = p.in[20] + (size_t)l * 1024 * 2048; J.lds_src = 2048; J.col0 = 0; J.N = 2048; J.nvalid = 2048; J.g = p.in[6] + l * 1024; J.dst = (bf16_t*)(ws + O_LAYER + l * L_SIZE + L_WKV); }
                else if (w == 1) { J.src = p.in[21] + (size_t)l * 1024 * 1024; J.lds_src = 1024; J.col0 = 0; J.N = 1024; J.nvalid = 1024; J.dst = (bf16_t*)(ws + O_LAYER + l * L_SIZE + L_WCOUT); }
                else if (w == 2) { J.src = p.in[22] + (size_t)l * 1024 * 4096; J.lds_src = 4096; J.col0 = 0; J.N = 4096; J.nvalid = 4096; J.g = p.in[7] + l * 1024; J.dst = (bf16_t*)(ws + O_LAYER + l * L_SIZE + L_W1); }
                else { J.src = p.in[23] + (size_t)l * 4096 * 1024; J.lds_src = 1024; J.col0 = 0; J.K = 4096; J.N = 1024; J.nvalid = 1024; J.ldd = 4096; J.dst = (bf16_t*)(ws + O_LAYER + l * L_SIZE + L_W2); }
                break;
            }
            const int nt = cvt_tiles(J);
            for (int t = c; t < nt; t += G) cvt_tile(J, t, tl, wv);
        }
        for (int l = 0; l < 2; ++l) { const float* src = p.in[19] + (size_t)l * 1024 * 1024; const float* g = p.in[5] + l * 1024; bf16_t* dst = (bf16_t*)(ws + O_LAYER + l * L_SIZE + L_WQG);
            for (int i = c * NTHREADS + tid; i < 1024 * 1024 / 8; i += G * NTHREADS) { const int row = i >> 7; const float s = g[row] * 0.0625f;
                const f32x4 a = *(const f32x4*)(src + (size_t)i * 8), b = *(const f32x4*)(src + (size_t)i * 8 + 4); pg8::st_bf16x8(dst + (size_t)i * 8, a * s, b * s); } }
        const int gw = c * 8 + (tid >> 6), nw = G * 8;
        rows_to_bf16(x_prompt, x_sample, T, TP, R0, rowss, gw, nw, true);
        rows_to_bf16(p.in[2], p.in[3], 1536, 512, (bf16_t*)(ws + O_MEMB), memss, gw, nw, false);
        if (c == 0 && tid < 64) { const float* lv = p.in[15]; float a = lv[tid] * lv[64 + tid], b = lv[128 + tid] * lv[192 + tid];
#pragma unroll
            for (int o = 32; o >= 1; o >>= 1) { a += __shfl_xor(a, o); b += __shfl_xor(b, o); }
            if (tid == 0) lamp[0] = __expf(a) - __expf(b) + LAMBDA_INIT1; }
        __syncthreads();
    }
    SEAM(0);
    if (IN(1)) {
        { pg8::Sched S{256, 5, G, c, 0, (const char*)R0, (const char*)(ws + O_WA), 256 * 1024 * 2, 256 * 1024 * 2, 0};
          pg8::EpiQKG E{R1, R1 + (size_t)T * 512, (float*)(ws + O_GATES), p.in[11], rowss};
          pg8::gemm_phase(lds, 1024, 1024, 1024, S, E, wv); }
        { pg8::Sched S{6, 256, G, c, 0, (const char*)(ws + O_WB), (const char*)R0, 256 * 1024 * 2, 256 * 1024 * 2, 0};
          pg8::EpiColScale E{(bf16_t*)p.out, T, rowss};
          pg8::gemm_phase(lds, 1024, 1024, 1024, S, E, wv); }
        { pg8::Sched S{6, 8, G, c, 0, (const char*)(ws + O_MEMB), (const char*)(ws + O_LAYER + L_WKV), 256 * 1024 * 2, 256 * 1024 * 2, 0};
          pg8::EpiPlain E{(bf16_t*)(ws + O_KVM), 2048, memss};
          pg8::gemm_phase(lds, 1024, 1024, 1024, S, E, wv); }
    }
    SEAM(1);
    if (IN(2)) {
        for (int rep_ = 0; rep_ < REP_SCAN; ++rep_)
        if (G == 256) { if (c < 192) { const int q_ = c >> 3; scan::run(p, lds, (((q_ >> 2) * 8 + (c & 7)) << 2) + (q_ & 3), wv); } }
        else for (int item = c; item < 192; item += G) scan::run(p, lds, item, wv);
        { pg8::SchedM S{G, c, (const char*)(ws + O_KVM), (const char*)(ws + O_LAYER + L_WQG)}; pg8::EpiPlain E{(bf16_t*)(ws + O_MB), 1024, nullptr}; pg8::gemm_phase(lds, 256, 2048, 1024, S, E, wv); }
        { pg8::SchedN S{G, c, (const char*)(ws + O_KVM), (const char*)(ws + O_LAYER + L_WCOUT)}; pg8::EpiPlain E{(bf16_t*)(ws + O_NB), 1024, nullptr}; pg8::gemm_phase(lds, 256, 1024, 2048, S, E, wv); }
    }
    SEAM(2);
    if (IN(3)) rows_to_bf16(x_prompt, x_sample, T, TP, R1, nullptr, c * 8 + (tid >> 6), G * 8, false);
    SEAM(3);
    if (IN(4)) { pg8::Sched S{256, 4, G, c, 0, (const char*)R1, (const char*)(ws + O_WO), 256 * 1024 * 2, 256 * 1024 * 2, 0};
        pg8::EpiOGate E{R2, R0, p.in[12], rowss}; pg8::gemm_phase(lds, 1024, 1024, 1024, S, E, wv); }
    SEAM(4);
    if (IN(5)) { pg8::Sched S{256, 4, G, c, 0, (const char*)R2, (const char*)(ws + O_WAOUT), 256 * 1024 * 2, 256 * 1024 * 2, 0};
        pg8::EpiRes<0> E{x_prompt, x_sample, p.out, R0, rowss + 1 * 4 * T}; pg8::gemm_phase(lds, 1024, 1024, 1024, S, E, wv); }
    SEAM(5);
#define CROSS_MLP(PH, XB, XA, HID, LOFF, SS0, SS1, SS2, W2MODE)                                                                                              \
    if (IN(PH)) { pg8::Sched S{256, 4, G, c, 0, (const char*)(XB), (const char*)(ws + O_MB), 256 * 1024 * 2, 256 * 1024 * 2, 1024 * 1024 * 2};    \
        pg8::EpiSoftmax E{(XA), rowss + (SS0) * 4 * T}; pg8::gemm_phase(lds, 1024, 1024, 1024, S, E, wv); }                                                  \
    SEAM(PH);                                                                                                                                        \
    if (IN(PH + 1)) { pg8::Sched S{256, 4, G, c, 0, (const char*)(XA), (const char*)(ws + O_NB), 256 * 1024 * 2, 256 * 1024 * 2, 1024 * 1024 * 2}; \
        pg8::EpiRes<1> E{nullptr, nullptr, p.out, (XB), rowss + (SS1) * 4 * T}; pg8::gemm_phase(lds, 1024, 1024, 1024, S, E, wv); }            \
    SEAM(PH + 1);                                                                                                                                    \
    for (int half = 0; half < 2; ++half) {                                                                                                           \
        if (IN(PH + 2 + 2 * half)) { pg8::Sched S{128, 16, G, c, half * 128, (const char*)(XB), (const char*)(ws + O_LAYER + (LOFF) + L_W1), 256 * 1024 * 2, 256 * 1024 * 2, 0}; \
            pg8::EpiSqRelu E{(HID), 4096, rowss + (SS1) * 4 * T, half * TP}; pg8::gemm_phase(lds, 1024, 1024, 1024, S, E, wv); }                             \
        SEAM(PH + 2 + 2 * half);                                                                                                                     \
        if (IN(PH + 3 + 2 * half)) { pg8::Sched S{128, 4, G, c, half * 128, (const char*)((HID) - (size_t)half * TP * 4096), (const char*)(ws + O_LAYER + (LOFF) + L_W2), 256 * 4096 * 2, 256 * 4096 * 2, 0}; \
            pg8::EpiRes<W2MODE> E{nullptr, nullptr, p.out, (XB), rowss + (SS2) * 4 * T}; pg8::gemm_phase(lds, 4096, 4096, 4096, S, E, wv); }         \
        SEAM(PH + 3 + 2 * half);                                                                                                                     \
    }
    CROSS_MLP(6, R0, R1, R1, 0, 1, 2, 3, 1)
#define ATTN_GRP(grp) { \
        constexpr int PH = 12 + 2 * grp; \
        if (IN(PH)) { \
            { pg8::Sched S{128, 12, G, c, grp * 128, (const char*)R0, (const char*)(ws + O_WQKV), 256 * 1024 * 2, 256 * 1024 * 2, 0}; \
              pg8::EpiQKVh E{R1, rowss + 3 * 4 * T, grp * TP}; pg8::gemm_phase(lds, 1024, 1024, 1024, S, E, wv); } \
            if (grp == 0) { pg8::Sched S{6, 8, G, c, 0, (const char*)(ws + O_MEMB), (const char*)(ws + O_LAYER + L_SIZE + L_WKV), 256 * 1024 * 2, 256 * 1024 * 2, 0}; \
              pg8::EpiPlain E{(bf16_t*)(ws + O_KVM), 2048, memss}; pg8::gemm_phase(lds, 1024, 1024, 1024, S, E, wv); } \
        } \
        SEAM(PH); \
        if (IN(PH + 1)) { \
            const float lam = lamp[0]; \
            const int S = grp ? 8192 : 16384, nqb = S / 128; \
            for (int rep_ = 0; rep_ < REP_ATTN; ++rep_) \
            for (int item = ((c & 7) * (G >> 3) + (c >> 3)); item < 2048; item += G) { \
                const int qb = item % nqb, sh = item / nqb, head = sh & 7, sq = sh >> 3; \
                const bf16_t* base = R1 + ((size_t)head * TP + (size_t)sq * S) * 128; \
                dattn::body4(base, base + (size_t)8 * TP * 128, base + (size_t)16 * TP * 128, \
                            (bf16_t*)p.out + ((size_t)grp * TP + (size_t)sq * S) * 1024 + head * 128, S, qb * 128, head, lam, p.in[18], p.in[16], (char*)lds_raw, lds, wv); \
            } \
            __syncthreads(); \
            if (grp == 0) { \
                { pg8::SchedM S2{G, c, (const char*)(ws + O_KVM), (const char*)(ws + O_LAYER + L_SIZE + L_WQG)}; pg8::EpiPlain E{(bf16_t*)(ws + O_MB), 1024, nullptr}; pg8::gemm_phase(lds, 256, 2048, 1024, S2, E, wv); } \
                { pg8::SchedN S2{G, c, (const char*)(ws + O_KVM), (const char*)(ws + O_LAYER + L_SIZE + L_WCOUT)}; pg8::EpiPlain E{(bf16_t*)(ws + O_NB), 1024, nullptr}; pg8::gemm_phase(lds, 256, 1024, 2048, S2, E, wv); } \
            } \
        } \
        SEAM(PH + 1); \
    }
    ATTN_GRP(0)
    ATTN_GRP(1)
#undef ATTN_GRP
    if (IN(16)) { pg8::Sched S{256, 4, G, c, 0, (const char*)p.out, (const char*)(ws + O_WBOUT), 256 * 1024 * 2, 256 * 1024 * 2, 0};
        pg8::EpiRes<1> E{nullptr, nullptr, p.out, R0, rowss + 4 * 4 * T}; pg8::gemm_phase(lds, 1024, 1024, 1024, S, E, wv); }
    SEAM(16);
    CROSS_MLP(17, R0, R1, R1, L_SIZE, 4, 5, 6, 1)
    if (IN(23)) {
        const float* gf = p.in[8]; const float* ss = rowss + 6 * 4 * T; const int lane = tid & 63;
        for (int row = c * 8 + (tid >> 6); row < T; row += G * 8) { const float sc = rstd4(ss, row);
#pragma unroll
            for (int i = 0; i < 2; ++i) { const int col = i * 512 + lane * 8; const u32x4 w = *(const u32x4*)(R0 + (size_t)row * 1024 + col);
                const f32x4 g0 = *(const f32x4*)(gf + col), g1 = *(const f32x4*)(gf + col + 4); float* op = p.out + (size_t)row * 1024 + col;
                *(f32x4*)op = (f32x4){bflo(w.x) * g0[0], bfhi(w.x) * g0[1], bflo(w.y) * g0[2], bfhi(w.y) * g0[3]} * sc;
                *(f32x4*)(op + 4) = (f32x4){bflo(w.z) * g1[0], bfhi(w.z) * g1[1], bflo(w.w) * g1[2], bfhi(w.w) * g1[3]} * sc; } }
    }
#undef IN
#undef SEAM
#undef tid
}

extern "C" void kernel_launch(void* const* d_in, const int* in_sizes, int n_in, void* d_out, int out_size, void* d_ws, size_t ws_size, hipStream_t stream) {
    static int grid = 0;
    if (grid == 0) {
        if (n_in != 24 || out_size != T * DM || ws_size < WS_END) { fprintf(stderr, "kernel_launch: unexpected shapes: n_in %d out %d ws %zu (need %zu)\n", n_in, out_size, ws_size, (size_t)WS_END); grid = -1; return; }
        int dev = 0, cus = 0, per_cu = 0;
        hipGetDevice(&dev); hipDeviceGetAttribute(&cus, hipDeviceAttributeMultiprocessorCount, dev);
        if (hipFuncSetAttribute((const void*)fwd_kernel, hipFuncAttributeMaxDynamicSharedMemorySize, LDS_BYTES) != hipSuccess) { fprintf(stderr, "kernel_launch: hipFuncSetAttribute failed\n"); grid = -1; return; }
        if (hipOccupancyMaxActiveBlocksPerMultiprocessor(&per_cu, (const void*)fwd_kernel, NTHREADS, LDS_BYTES) != hipSuccess || per_cu < 1) { fprintf(stderr, "kernel_launch: occupancy query says %d\n", per_cu); per_cu = 1; }
        (void)hipGetLastError();
        grid = cus;
    }
    if (grid < 0) return;
    if (hipMemsetAsync((char*)d_ws + O_MISC + 16384, 0, 256, stream) != hipSuccess) { fprintf(stderr, "kernel_launch: memset of the barrier word failed\n"); return; }
    Params p{};
    for (int i = 0; i < 24; ++i) p.in[i] = (const float*)d_in[i];
    p.out = (float*)d_out; p.ws = (unsigned char*)d_ws; p.ph_lo = 0; p.ph_hi = 24;
    void* args[] = {&p};
    hipError_t e = hipLaunchCooperativeKernel((const void*)fwd_kernel, dim3(grid), dim3(NTHREADS), args, LDS_BYTES, stream);
    if (e != hipSuccess) fprintf(stderr, "kernel_launch: cooperative launch failed: %s (grid %d)\n", hipGetErrorString(e), grid);
}
```
